# Optimizing an MI355X kernel written in HIP

```python
import jax, jax.numpy as jnp
from jax import lax
import numpy as np

D_MODEL = 1024
BATCH = 32
SEQ = 256
DEPTH = 4
DEC_BATCH = 4
DEC_SEQ = 4096
PAST_LEN = 512

GRID_W = 64
N_AB = (DEPTH + 1) // 2
N_C = DEPTH // 2
MLA_HEADS = 8
QK_NOPE_DIM = 64
QK_ROPE_DIM = 32
V_HEAD_DIM = 64
Q_LORA_RANK = 384
KV_LORA_RANK = 256
ROPE_BASE = 10000.0
ROPE_AXIS_DIM = QK_ROPE_DIM // 2
Q_BLOCK = 128
ATTN_SCALE = (QK_NOPE_DIM + QK_ROPE_DIM) ** -0.5
GMLP_GROUPS = 8
GMLP_CHUNK = 128
GMLP_WIDTH = D_MODEL // 2
GMLP_GROUP_DIM = GMLP_WIDTH // GMLP_GROUPS
QA_END = Q_LORA_RANK
KVA_END = QA_END + KV_LORA_RANK
KPE_END = KVA_END + QK_ROPE_DIM
IN_AB = KPE_END + 2 * GMLP_WIDTH
MIX_AB = MLA_HEADS * V_HEAD_DIM + GMLP_WIDTH
POOL_WINDOWS = (2, 4, 8, 16)
POOL_GROUP_DIM = D_MODEL // len(POOL_WINDOWS)
D_FF = 4 * D_MODEL
N_MOD = 6
EPS = 1e-6

kernel_name = 'hybrid_mla_gmlp_pool_diffusion_step'


def rms_norm(x, g):
    x32 = x.astype(jnp.float32)
    y = x32 * lax.rsqrt(jnp.mean(x32 * x32, axis=-1, keepdims=True) + EPS)
    return (y * g.astype(jnp.float32)).astype(x.dtype)


def axial_angles(n_tokens):
    rows = n_tokens // GRID_W
    row = jnp.repeat(jnp.arange(rows), GRID_W).astype(jnp.float32)
    col = jnp.tile(jnp.arange(GRID_W), rows).astype(jnp.float32)
    inv = ROPE_BASE ** (-jnp.arange(0, ROPE_AXIS_DIM, 2, dtype=jnp.float32) / ROPE_AXIS_DIM)
    return jnp.stack([row[:, None] * inv, col[:, None] * inv], axis=1)


def apply_axial_rope(x, ang):
    B, T, H, _ = x.shape
    F = QK_ROPE_DIM // 4
    xr = x.reshape(B, T, H, 2, 2, F)
    x1, x2 = xr[..., 0, :], xr[..., 1, :]
    cos = jnp.cos(ang)[:, None].astype(x.dtype)
    sin = jnp.sin(ang)[:, None].astype(x.dtype)
    out = jnp.stack([x1 * cos - x2 * sin, x2 * cos + x1 * sin], axis=-2)
    return out.reshape(x.shape)


def mla_attention(q_nope, q_pe, k_nope, k_pe, v):
    B, T, H, _ = q_nope.shape
    nb = T // Q_BLOCK
    qn = q_nope.reshape(B, nb, Q_BLOCK, H, QK_NOPE_DIM).swapaxes(0, 1)
    qp = q_pe.reshape(B, nb, Q_BLOCK, H, QK_ROPE_DIM).swapaxes(0, 1)

    def block(args):
        qn_b, qp_b = args
        s = (jnp.einsum('bqhd,bkhd->bhqk', qn_b, k_nope)
             + jnp.einsum('bqhd,bkd->bhqk', qp_b, k_pe))
        p = jax.nn.softmax(s.astype(jnp.float32) * ATTN_SCALE, axis=-1).astype(v.dtype)
        return jnp.einsum('bhqk,bkhd->bqhd', p, v)

    o = lax.map(block, (qn, qp))
    return o.swapaxes(0, 1).reshape(B, T, H * V_HEAD_DIM)


def chunk_gmlp(u, v, v_g, w_s, b_s):
    B, T, _ = v.shape
    vn = rms_norm(v, v_g).reshape(B, T // GMLP_CHUNK, GMLP_CHUNK, GMLP_GROUPS, GMLP_GROUP_DIM)
    s = jnp.einsum('gpq,bnqgc->bnpgc', w_s, vn) + b_s.T[:, :, None]
    return u * s.reshape(B, T, GMLP_WIDTH)


def mixer_ab(h, w_in, q_a_g, kv_a_g, w_q_b, w_kv_b, v_g, w_s, b_s, w_out, ang, ctx_ckv, ctx_kpe):
    B, T, _ = h.shape
    z = h @ w_in
    q_a, kv_a, k_pe = z[..., :QA_END], z[..., QA_END:KVA_END], z[..., KVA_END:KPE_END]
    uv = jax.nn.gelu(z[..., KPE_END:])
    q = (rms_norm(q_a, q_a_g) @ w_q_b).reshape(B, T, MLA_HEADS, QK_NOPE_DIM + QK_ROPE_DIM)
    q_nope, q_pe = q[..., :QK_NOPE_DIM], q[..., QK_NOPE_DIM:]
    c_kv = rms_norm(kv_a, kv_a_g)
    if ang is None:
        keys_ckv, keys_kpe = c_kv, k_pe
    else:
        q_pe = apply_axial_rope(q_pe, ang)
        k_pe_rot = apply_axial_rope(k_pe[:, :, None, :], ang)[:, :, 0, :]
        keys_ckv = jnp.concatenate([ctx_ckv, c_kv], axis=1)
        keys_kpe = jnp.concatenate([ctx_kpe, k_pe_rot], axis=1)
    L = keys_ckv.shape[1]
    kv = (keys_ckv @ w_kv_b).reshape(B, L, MLA_HEADS, QK_NOPE_DIM + V_HEAD_DIM)
    k_nope, v = kv[..., :QK_NOPE_DIM], kv[..., QK_NOPE_DIM:]
    attn = mla_attention(q_nope, q_pe, k_nope, keys_kpe, v)
    gm = chunk_gmlp(uv[..., :GMLP_WIDTH], uv[..., GMLP_WIDTH:], v_g, w_s, b_s)
    out = jnp.concatenate([attn, gm], axis=-1) @ w_out
    return out, c_kv, k_pe


def pool_mixer(h, w_pool, scale):
    B, T, _ = h.shape
    h32 = h.astype(jnp.float32)
    cs = jnp.concatenate([jnp.zeros_like(h32[:, :1]), jnp.cumsum(h32, axis=1)], axis=1)
    t = jnp.arange(T)
    outs = []
    for gi, w in enumerate(POOL_WINDOWS):
        sl = slice(gi * POOL_GROUP_DIM, (gi + 1) * POOL_GROUP_DIM)
        start = jnp.clip(t - w // 2, 0, T)
        end = jnp.clip(t + w // 2, 0, T)
        cnt = (end - start).astype(jnp.float32)[None, :, None]
        mean = (cs[:, end, sl] - cs[:, start, sl]) / cnt
        outs.append((mean - h32[..., sl]).astype(h.dtype) @ w_pool[gi])
    return jnp.concatenate(outs, axis=-1) * scale


def squared_relu_mlp(h, w1, w2):
    a = jax.nn.relu(h @ w1)
    return (a * a) @ w2


def trunk(x, cond, ang, ctx_ckv, ctx_kpe, w_mod, b_mod, norm1_g, norm2_g, w_in_ab, q_a_g, kv_a_g,
          w_q_b, w_kv_b, gmlp_v_g, w_spatial, b_spatial, w_out_ab, w_pool, pool_scale,
          w_ff1, w_ff2, final_g):
    ckv_list, kpe_list = [], []
    for l in range(DEPTH):
        mod = (jax.nn.silu(cond) @ w_mod[l] + b_mod[l]).reshape(-1, 1, N_MOD * D_MODEL)
        sh1, sc1, g1, sh2, sc2, g2 = jnp.split(mod, N_MOD, axis=-1)
        h = rms_norm(x, norm1_g[l]) * (1 + sc1) + sh1
        if l % 2 == 0:
            i = l // 2
            c_ckv = None if ang is None else ctx_ckv[:, i]
            c_kpe = None if ang is None else ctx_kpe[:, i]
            mix, ckv, kpe = mixer_ab(h, w_in_ab[i], q_a_g[i], kv_a_g[i], w_q_b[i], w_kv_b[i],
                                     gmlp_v_g[i], w_spatial[i], b_spatial[i], w_out_ab[i],
                                     ang, c_ckv, c_kpe)
            if ang is None:
                ckv_list.append(ckv)
                kpe_list.append(kpe)
        else:
            mix = pool_mixer(h, w_pool[l // 2], pool_scale[l // 2])
        x = x + g1 * mix
        h = rms_norm(x, norm2_g[l]) * (1 + sc2) + sh2
        x = x + g2 * squared_relu_mlp(h, w_ff1[l], w_ff2[l])
    return rms_norm(x, final_g), ckv_list, kpe_list


def setup_inputs(seed: int = 0) -> dict:
    key = jax.random.key(seed)
    ks = jax.random.split(key, 26)
    f32 = jnp.float32

    def nrm(k, shape, scale):
        return jax.random.normal(k, shape, f32) * scale

    def gain(k, shape):
        return 1.0 + 0.02 * jax.random.normal(k, shape, f32)

    D = D_MODEL
    return {
        'x_prompt': nrm(ks[0], (BATCH, SEQ, D), 1.0),
        'x_sample': nrm(ks[1], (DEC_BATCH, DEC_SEQ, D), 1.0),
        'cache_ckv': nrm(ks[2], (DEC_BATCH, N_AB, PAST_LEN, KV_LORA_RANK), 1.0),
        'cache_kpe': nrm(ks[3], (DEC_BATCH, N_AB, PAST_LEN, QK_ROPE_DIM), 1.0),
        'c': nrm(ks[4], (DEC_BATCH, D), 1.0),
        'c_ctx': nrm(ks[5], (D,), 1.0),
        'w_mod': nrm(ks[6], (DEPTH, D, N_MOD * D), 0.5 * D ** -0.5),
        'b_mod': nrm(ks[7], (DEPTH, N_MOD * D), 0.02),
        'norm1_g': gain(ks[8], (DEPTH, D)),
        'norm2_g': gain(ks[9], (DEPTH, D)),
        'w_in_ab': nrm(ks[10], (N_AB, D, IN_AB), D ** -0.5),
        'q_a_g': gain(ks[11], (N_AB, Q_LORA_RANK)),
        'kv_a_g': gain(ks[12], (N_AB, KV_LORA_RANK)),
        'w_q_b': nrm(ks[13], (N_AB, Q_LORA_RANK, MLA_HEADS * (QK_NOPE_DIM + QK_ROPE_DIM)), Q_LORA_RANK ** -0.5),
        'w_kv_b': nrm(ks[14], (N_AB, KV_LORA_RANK, MLA_HEADS * (QK_NOPE_DIM + V_HEAD_DIM)), KV_LORA_RANK ** -0.5),
        'gmlp_v_g': gain(ks[15], (N_AB, GMLP_WIDTH)),
        'w_spatial': nrm(ks[16], (N_AB, GMLP_GROUPS, GMLP_CHUNK, GMLP_CHUNK), GMLP_CHUNK ** -0.5),
        'b_spatial': gain(ks[17], (N_AB, GMLP_GROUPS, GMLP_CHUNK)),
        'w_out_ab': nrm(ks[18], (N_AB, MIX_AB, D), MIX_AB ** -0.5),
        'w_pool': nrm(ks[19], (N_C, len(POOL_WINDOWS), POOL_GROUP_DIM, POOL_GROUP_DIM), POOL_GROUP_DIM ** -0.5),
        'pool_scale': gain(ks[20], (N_C, D)),
        'w_ff1': nrm(ks[21], (DEPTH, D, D_FF), D ** -0.5),
        'w_ff2': nrm(ks[22], (DEPTH, D_FF, D), D_FF ** -0.5),
        'final_g': gain(ks[23], (D,)),
    }


def reference(x_prompt, x_sample, cache_ckv, cache_kpe, c, c_ctx, w_mod, b_mod, norm1_g, norm2_g,
              w_in_ab, q_a_g, kv_a_g, w_q_b, w_kv_b, gmlp_v_g, w_spatial, b_spatial, w_out_ab,
              w_pool, pool_scale, w_ff1, w_ff2, final_g):
    y_prompt, ckv_list, kpe_list = trunk(
        x_prompt, c_ctx, None, None, None, w_mod, b_mod, norm1_g, norm2_g, w_in_ab, q_a_g, kv_a_g,
        w_q_b, w_kv_b, gmlp_v_g, w_spatial, b_spatial, w_out_ab, w_pool, pool_scale,
        w_ff1, w_ff2, final_g)
    new_ckv = jnp.stack(ckv_list, axis=1)
    new_kpe = jnp.stack(kpe_list, axis=1)
    ang = axial_angles(x_sample.shape[1])
    y_sample, _, _ = trunk(
        x_sample, c, ang, cache_ckv, cache_kpe, w_mod, b_mod, norm1_g, norm2_g, w_in_ab, q_a_g, kv_a_g,
        w_q_b, w_kv_b, gmlp_v_g, w_spatial, b_spatial, w_out_ab, w_pool, pool_scale,
        w_ff1, w_ff2, final_g)
    return (y_prompt, y_sample, new_ckv, new_kpe)
```

```cpp
#include <hip/hip_runtime.h>
#include <hip/hip_cooperative_groups.h>
#include <cstdio>
#include <cstdint>
namespace cg = cooperative_groups;

#ifndef MK_COOP
#define MK_COOP 1
#endif

#define DI __device__ __forceinline__
#define LAS __attribute__((address_space(3)))
typedef unsigned short bf16_t;
typedef short bf16x8 __attribute__((ext_vector_type(8)));
typedef float f32x2 __attribute__((ext_vector_type(2)));
typedef float f32x4 __attribute__((ext_vector_type(4)));
typedef float f32x16 __attribute__((ext_vector_type(16)));
typedef unsigned u32x2 __attribute__((ext_vector_type(2)));
typedef unsigned u32x4 __attribute__((ext_vector_type(4)));
typedef __bf16 bf16x2_t __attribute__((ext_vector_type(2)));

constexpr int D = 1024, T_CTX = 8192, T_LAT = 16384, T = T_CTX + T_LAT;
constexpr int LLAT = 4608, KR = T_CTX + 4 * LLAT;
constexpr int NZ = 1792, FF = 4096;
constexpr int MODW = 6144;
constexpr float EPS = 1e-6f;
constexpr float QSCALE = 0.10206207261596577f * 1.4426950408889634f;
constexpr size_t OUT_CKV = (size_t)T * D, OUT_KPE = OUT_CKV + (size_t)32 * 2 * 256 * 256;
constexpr size_t KF_CTX = (size_t)32 * 8 * 256 * 96, VT_CTX = (size_t)32 * 8 * 64 * 256;

constexpr size_t WS_WIN = 0;
constexpr size_t WS_WQB = WS_WIN + (size_t)2 * NZ * 1024 * 2;
constexpr size_t WS_WK = WS_WQB + (size_t)2 * 768 * 384 * 2;
constexpr size_t WS_WV = WS_WK + (size_t)2 * 512 * 256 * 2;
constexpr size_t WS_WOUT = WS_WV + (size_t)2 * 512 * 256 * 2;
constexpr size_t WS_WPOOL = WS_WOUT + (size_t)2 * 1024 * 1024 * 2;
constexpr size_t WS_WSP = WS_WPOOL + (size_t)2 * 1024 * 256 * 2;
constexpr size_t WS_WFF1 = WS_WSP + (size_t)2 * 8 * 128 * 128 * 2;
constexpr size_t WS_WFF2 = WS_WFF1 + (size_t)4 * FF * 1024 * 2;
constexpr size_t WS_MOD = WS_WFF2 + (size_t)4 * FF * 1024 * 2;
constexpr size_t WS_H = WS_MOD + (size_t)4 * 5 * MODW * 4;
constexpr size_t WS_U = WS_H + (size_t)T * 1024 * 2;
constexpr size_t WS_Z = WS_U;
constexpr size_t WS_QN = WS_Z + (size_t)T * NZ * 2;
constexpr size_t WS_CKV = WS_QN + (size_t)T * 384 * 2;
constexpr size_t WS_Q = WS_CKV + (size_t)KR * 256 * 2;
constexpr size_t WS_KF = WS_Q + (size_t)T * 768 * 2;
constexpr size_t WS_VT = WS_KF + (size_t)KR * 8 * 96 * 2;
constexpr size_t WS_VN = WS_VT + (size_t)KR * 512 * 2;
constexpr size_t WS_END1 = WS_VN + (size_t)T * 512 * 2;
constexpr size_t WS_FFH = WS_U;
constexpr size_t WS_PD = WS_U;
constexpr size_t WS_END2 = WS_FFH + (size_t)T * FF * 2;
constexpr size_t WS_DELTA = WS_END2;
static_assert(WS_DELTA + (size_t)T * 1024 * 2 <= WS_END1, "delta");
constexpr size_t WS_NEED = WS_END1 > WS_END2 ? WS_END1 : WS_END2;
static_assert(WS_NEED <= (size_t)402653184, "workspace map exceeds 4x largest tensor");

constexpr int XST_OFF = 131072;
constexpr int LDS_BYTES = 131072 + 64;
constexpr size_t WS_CTL = (WS_NEED + 255) & ~(size_t)255, CTL_BYTES = 32768;
constexpr size_t WS_KPE = WS_CTL + CTL_BYTES;
constexpr size_t WS_TOTAL = WS_KPE + (size_t)KR * 32 * 2;
static_assert(WS_TOTAL <= (size_t)402653184, "ctl");
constexpr int NPHASE = 32;

struct Params {
    const float* in[24];
    float* out;
    unsigned char* ws;
    int ph_lo, ph_hi;
    int coop, pad;
};
typedef const __attribute__((address_space(4))) Params* KP;
enum { I_XP = 0, I_XS, I_CCKV, I_CKPE, I_C, I_CCTX, I_WMOD, I_BMOD, I_N1G, I_N2G, I_WIN, I_QAG, I_KVAG, I_WQB, I_WKVB, I_VG, I_WSP, I_BSP, I_WOUT, I_WPOOL, I_PSCALE, I_WFF1, I_WFF2, I_FG };

DI unsigned pk_bf16(float lo, float hi) { f32x2 v = {lo, hi}; bf16x2_t b = __builtin_convertvector(v, bf16x2_t); return __builtin_bit_cast(unsigned, b); }
DI float bf_lo(unsigned u) { return __builtin_bit_cast(float, u << 16); }
DI float bf_hi(unsigned u) { return __builtin_bit_cast(float, u & 0xffff0000u); }
DI float bf1(bf16_t u) { return __builtin_bit_cast(float, (unsigned)u << 16); }
DI bf16_t f2bf(float f) { return (bf16_t)(pk_bf16(f, 0.f) & 0xffffu); }
DI float wave_sum(float v) {
#pragma unroll
    for (int o = 32; o; o >>= 1) v += __shfl_xor(v, o);
    return v;
}
DI int cond_of_row(int row) { return row < T_CTX ? 4 : ((row - T_CTX) >> 12); }
DI void sincos_rr(float x, float& s, float& c) {
    const float n = rintf(x * 0.15915494309189535f);
    float r = fmaf(-n, 6.2831854820251465f, x);
    r = fmaf(-n, -1.7484556000744883e-07f, r);
    s = __sinf(r); c = __cosf(r);
}
DI float rope_inv(int f) { return exp2f(-(float)f * 1.6609640474436813f); }
DI float gelu_tanh(float x) {
    const float u = 0.7978845608028654f * (x + 0.044715f * x * x * x);
    const float t = __builtin_amdgcn_exp2f(-2.885390081777927f * u);
    return x * __builtin_amdgcn_rcpf(1.f + t);
}

namespace pg8 {
constexpr int BM = 256, BK = 64, HALF = 128, HTB = HALF * BK * 2, NXCD = 8, WGM = 8;
DI int lds_byte(int r, int c) { const int st = (r >> 4) * 2 + (c >> 5), rr = r & 15, cc = c & 31, ob = rr * 64 + cc * 2; return st * 1024 + (ob ^ (((ob >> 9) & 1) << 5)); }
DI void stage_rc(int b, int& R, int& C) { const int st = b / 1024, sb = b % 1024, swz = sb ^ (((sb >> 9) & 1) << 5); R = (st >> 1) * 16 + swz / 64; C = (st & 1) * 32 + (swz % 64) / 2; }
DI int perm32(int rho) { const int n = rho >> 4, i = rho & 15; return 8 * (i >> 2) + 4 * n + (i & 3); }
struct Unit { int pm, pn, kt0, nt, role, slot, mh; };
struct Gemm { const bf16_t* A; const bf16_t* Bt; int lda, ldb, K, a_pn_step, nM, nN, rot; float* P; unsigned* flags; int tiledA, tiledB, msplit; };

DI bool next_unit(int bid_o, const Gemm& g, int i, Unit& u) {
    const int G = gridDim.x; int c = bid_o + g.rot; if (c >= G) c -= G;
    const int nwg = g.nM * g.nN, ntf = g.K / BK;
    const int R = nwg / G, r = nwg - R * G;
    const bool split = g.P != nullptr && r > 0 && 2 * r <= G;
    long L; u.kt0 = 0; u.nt = ntf; u.role = 0; u.slot = 0; u.mh = 0;
    const bool msp = g.msplit && r > 0 && 2 * r <= G;
    if (msp) {
        if (i < R) L = (long)i * G + c;
        else if (i == R && c < 2 * r) { L = (long)R * G + (c >> 1); u.mh = 1 + (c & 1); }
        else return false;
    } else
    if (split && c < 2 * r) {
        const bool prod = (c & 1) == 0;
        if (i > R) return false;
        if (prod ? (i == 0) : (i == R)) { L = (long)R * G + (c >> 1); u.nt = ntf / 2; u.kt0 = prod ? 0 : ntf / 2; u.role = prod ? 1 : 2; u.slot = c >> 1; }
        else L = (long)(prod ? i - 1 : i) * G + c;
    } else {
        L = (long)i * G + c;
        if (split ? (i >= R) : (L >= nwg)) return false;
    }
    int wgid = (int)L; { const int q = nwg / NXCD, rr = nwg % NXCD, xcd = wgid % NXCD, off = wgid / NXCD; wgid = (xcd < rr ? xcd * (q + 1) : rr * (q + 1) + (xcd - rr) * q) + off; }
    const int nig = WGM * g.nN, gid = wgid / nig, fm = gid * WGM, gsz = (g.nM - fm) < WGM ? (g.nM - fm) : WGM;
    u.pm = fm + ((wgid % nig) % gsz); u.pn = (wgid % nig) / gsz; return true;
}

template <class EpiT>
DI void gemm_phase(int tid_o, int bid_o, LAS unsigned char* lds, const Gemm g, const EpiT& E) {
    const int tid = tid_o, wid = __builtin_amdgcn_readfirstlane(tid >> 6), lane = tid & 63, wr = wid >> 2, wc = wid & 3, fr = lane & 15, fq = lane >> 4;
    const int ldaE = g.tiledA ? 64 : g.lda, ldbE = g.tiledB ? 64 : g.ldb;
    unsigned voffA[2], voffB[2];
#pragma unroll
    for (int i = 0; i < 2; ++i) { int R, C; stage_rc(tid * 16 + i * 8192, R, C); const int Rb = (R & ~31) + perm32(R & 31);
        voffA[i] = (unsigned)(R * ldaE + C) * 2u; voffB[i] = (unsigned)(Rb * ldbE + C) * 2u; }
    const size_t kstepA = g.tiledA ? 32768 : 128, kstepB = g.tiledB ? 32768 : 128;
    const size_t hstepA = (size_t)HALF * ldaE * 2, hstepB = (size_t)HALF * ldbE * 2;
    const size_t tstepA = g.tiledA ? (size_t)512 * g.K : 2 * hstepA, tstepB = g.tiledB ? (size_t)512 * g.K : 2 * hstepB;
    const unsigned ldsw = (unsigned)wid * 1024u;
    const int aoff = lds_byte(wr * 64 + fr, fq * 8), boff = lds_byte(wc * 32 + fr, fq * 8);
#define PG8_SA(b, h) (((b) * 2 + (h)) * HTB)
#define PG8_SB(b, h) ((4 + (b) * 2 + (h)) * HTB)
#define PG8_STAGE(bufoff, gbase, voff) do { _Pragma("unroll") for (int _i = 0; _i < 2; ++_i) \
        __builtin_amdgcn_global_load_lds((const unsigned*)((const char*)(gbase) + (voff)[_i]), (LAS unsigned*)(lds + (bufoff) + ldsw + _i * 8192), 16, 0, 0); } while (0)
#define PG8_LDA(dst, b, h) do { _Pragma("unroll") for (int m = 0; m < 4; ++m) _Pragma("unroll") for (int k = 0; k < 2; ++k) dst[m][k] = *(const LAS bf16x8*)(lds + PG8_SA(b, h) + aoff + m * 2048 + k * 1024); } while (0)
#define PG8_LDB(dst, b, h) do { _Pragma("unroll") for (int n = 0; n < 2; ++n) _Pragma("unroll") for (int k = 0; k < 2; ++k) dst[n][k] = *(const LAS bf16x8*)(lds + PG8_SB(b, h) + boff + n * 2048 + k * 1024); } while (0)
#define PG8_MMA(ai, bj, At, Bt) do { __builtin_amdgcn_s_setprio(1); _Pragma("unroll") for (int m = 0; m < 4; ++m) _Pragma("unroll") for (int n = 0; n < 2; ++n) _Pragma("unroll") for (int k = 0; k < 2; ++k) \
        acc[ai][bj][m][n] = __builtin_amdgcn_mfma_f32_16x16x32_bf16(Bt[n][k], At[m][k], acc[ai][bj][m][n], 0, 0, 0); __builtin_amdgcn_s_setprio(0); } while (0)
#define PG8_WAIT_V(n) asm volatile("s_waitcnt vmcnt(" #n ")" ::: "memory")
#define PG8_WAIT_L(n) asm volatile("s_waitcnt lgkmcnt(" #n ")" ::: "memory")
#define PG8_BAR __builtin_amdgcn_s_barrier()
#define PG8_SCHED __builtin_amdgcn_sched_barrier(0)
    Unit cur, nxt; int ui = 0;
    if (!next_unit(bid_o, g, 0, cur)) return;
    f32x4 acc[2][2][4][2];
#pragma unroll
    for (int a = 0; a < 2; ++a)
#pragma unroll
        for (int b = 0; b < 2; ++b)
#pragma unroll
            for (int m = 0; m < 4; ++m)
#pragma unroll
                for (int n = 0; n < 2; ++n) acc[a][b][m][n] = (f32x4){0.f, 0.f, 0.f, 0.f};
    bf16x8 At[4][2], B0[2][2], B1[2][2];
    const char* cA = (const char*)g.A + (size_t)cur.pm * tstepA + (size_t)cur.pn * g.a_pn_step * 2 + (size_t)cur.kt0 * kstepA + (cur.mh == 2 ? hstepA : 0); const char* cB = (const char*)g.Bt + (size_t)cur.pn * tstepB + (size_t)cur.kt0 * kstepB;
    PG8_STAGE(PG8_SB(0, 0), cB, voffB); PG8_STAGE(PG8_SB(0, 1), cB + hstepB, voffB); PG8_STAGE(PG8_SA(0, 0), cA, voffA); PG8_STAGE(PG8_SA(0, 1), cA + (cur.mh ? 0 : hstepA), voffA);
    if (wr == 1) PG8_BAR;
    PG8_WAIT_V(2); PG8_BAR;
    PG8_STAGE(PG8_SB(1, 0), cB + kstepB, voffB); PG8_STAGE(PG8_SA(1, 0), cA + kstepA, voffA); PG8_STAGE(PG8_SB(1, 1), cB + hstepB + kstepB, voffB);
    PG8_WAIT_V(6); PG8_BAR;
    for (;;) {
        const bool has_next = next_unit(bid_o, g, ui + 1, nxt);
        const char* nA = has_next ? (const char*)g.A + (size_t)nxt.pm * tstepA + (size_t)nxt.pn * g.a_pn_step * 2 + (size_t)nxt.kt0 * kstepA + (nxt.mh == 2 ? hstepA : 0) : cA;
        const size_t hAc = cur.mh ? 0 : hstepA, hAn = has_next ? (nxt.mh ? 0 : hstepA) : hAc;
        const bool fullM = cur.mh == 0; const char* nB = has_next ? (const char*)g.Bt + (size_t)nxt.pn * tstepB + (size_t)nxt.kt0 * kstepB : cB;
        const int nt = cur.nt;
#pragma nounroll
        for (int t = 0; t < nt; t += 2) {
            const bool last = (t == nt - 2);
            const char* a1 = cA + (size_t)(t + 1) * kstepA;
            const char* a2 = last ? nA : cA + (size_t)(t + 2) * kstepA; const char* b2 = last ? nB : cB + (size_t)(t + 2) * kstepB;
            const char* a3 = a2 + kstepA; const char* b3 = b2 + kstepB;
            PG8_LDB(B0, 0, 0); PG8_LDB(B1, 0, 1); PG8_SCHED; PG8_LDA(At, 0, 0); PG8_STAGE(PG8_SA(1, 1), a1 + hAc, voffA);
            PG8_WAIT_V(8); PG8_WAIT_L(0); PG8_BAR; PG8_MMA(0, 0, At, B0); PG8_MMA(0, 1, At, B1); PG8_BAR; PG8_SCHED;
            PG8_LDA(At, 0, 1); PG8_STAGE(PG8_SB(0, 0), b2, voffB); PG8_STAGE(PG8_SB(0, 1), b2 + hstepB, voffB); PG8_STAGE(PG8_SA(0, 0), a2, voffA);
            PG8_WAIT_V(8); PG8_WAIT_L(0); PG8_BAR; if (fullM) { PG8_MMA(1, 0, At, B0); PG8_MMA(1, 1, At, B1); } PG8_BAR; PG8_SCHED;
            PG8_LDB(B0, 1, 0); PG8_LDB(B1, 1, 1); PG8_SCHED; PG8_LDA(At, 1, 0); PG8_STAGE(PG8_SA(0, 1), a2 + (last ? hAn : hAc), voffA);
            PG8_WAIT_V(8); PG8_WAIT_L(0); PG8_BAR; PG8_MMA(0, 0, At, B0); PG8_MMA(0, 1, At, B1); PG8_BAR; PG8_SCHED;
            PG8_LDA(At, 1, 1); PG8_STAGE(PG8_SB(1, 0), b3, voffB); PG8_STAGE(PG8_SB(1, 1), b3 + hstepB, voffB); PG8_STAGE(PG8_SA(1, 0), a3, voffA);
            PG8_WAIT_V(8); PG8_WAIT_L(0); PG8_BAR; if (fullM) { PG8_MMA(1, 0, At, B0); PG8_MMA(1, 1, At, B1); } PG8_BAR; PG8_SCHED;
        }
        if (wr == 0) PG8_BAR;
        if (cur.role == 1) {
            float* pp = g.P + (size_t)cur.slot * 65536 + tid * 4;
#pragma unroll
            for (int a = 0; a < 2; ++a)
#pragma unroll
                for (int b = 0; b < 2; ++b)
#pragma unroll
                    for (int m = 0; m < 4; ++m)
#pragma unroll
                        for (int n = 0; n < 2; ++n) *(f32x4*)(pp + (size_t)(((a * 2 + b) * 4 + m) * 2 + n) * 2048) = acc[a][b][m][n];
            asm volatile("s_waitcnt vmcnt(0)" ::: "memory");
            __syncthreads();
            if (tid == 0) { __builtin_amdgcn_fence(__ATOMIC_RELEASE, "agent"); asm volatile("s_waitcnt vmcnt(0)" ::: "memory"); __hip_atomic_fetch_add(g.flags + cur.slot, 1u, __ATOMIC_RELAXED, __HIP_MEMORY_SCOPE_AGENT); }
        } else {
            if (cur.role == 2) {
                if (tid == 0) {
                    unsigned sp = 0;
                    while (__hip_atomic_load(g.flags + cur.slot, __ATOMIC_RELAXED, __HIP_MEMORY_SCOPE_AGENT) == 0u) { __builtin_amdgcn_s_sleep(1); if (++sp > (1u << 24)) break; }
                    __builtin_amdgcn_fence(__ATOMIC_ACQUIRE, "agent"); asm volatile("s_waitcnt vmcnt(0)" ::: "memory");
                }
                __syncthreads();
            }
            E(acc, cur, wr, wc, fr, fq, cur.role == 2 ? g.P + (size_t)cur.slot * 65536 + tid * 4 : (const float*)nullptr);
        }
        if (!has_next) break;
#pragma unroll
        for (int a = 0; a < 2; ++a)
#pragma unroll
            for (int b = 0; b < 2; ++b)
#pragma unroll
                for (int m = 0; m < 4; ++m)
#pragma unroll
                    for (int n = 0; n < 2; ++n) acc[a][b][m][n] = (f32x4){0.f, 0.f, 0.f, 0.f};
        cur = nxt; cA = nA; cB = nB; ++ui;
        if (wr == 1) PG8_BAR;
    }
    PG8_WAIT_V(0);
    PG8_BAR;
#undef PG8_SA
#undef PG8_SB
#undef PG8_STAGE
#undef PG8_LDA
#undef PG8_LDB
#undef PG8_MMA
#undef PG8_WAIT_V
#undef PG8_WAIT_L
#undef PG8_BAR
#undef PG8_SCHED
}
}

enum { EM_Z = 0, EM_Q, EM_K, EM_VT, EM_RES, EM_FF1 };
template <int mode> struct Epi {
    bf16_t* O;
    float* X;
    const float* xin0; const float* xin1;
    const float* gate;
    const float* cscale;
    const bf16_t* kpe;
    DI void operator()(const f32x4 (&acc)[2][2][4][2], const pg8::Unit& u, int wr, int wc, int fr, int fq, const float* part) const {
        const int row0 = u.pm * 256 + wr * 64 + fr;
        const int col0 = u.pn * 256 + wc * 32 + 8 * fq;
        if (mode == EM_Z || mode == EM_FF1) {
            const int ld = mode == EM_Z ? NZ : FF;
            const bool gel = (mode == EM_Z) && (u.pn >= 3);
            const bool sq = (mode == EM_FF1);
#pragma unroll
            for (int ai = 0; ai < 2; ++ai)
#pragma unroll
                for (int m = 0; m < 4; ++m) {
                    bf16_t* rowp = sq ? O + (size_t)u.pm * 256 * FF + (size_t)(u.pn * 4 + (wc >> 1)) * 16384 + (size_t)(wr * 64 + fr + ai * 128 + m * 16) * 64 + (wc & 1) * 32 + 8 * fq
                                     : O + (size_t)(row0 + ai * 128 + m * 16) * ld + col0;
#pragma unroll
                    for (int bj = 0; bj < 2; ++bj) {
                        f32x4 v0 = acc[ai][bj][m][0], v1 = acc[ai][bj][m][1];
                        if (gel) {
#pragma unroll
                            for (int e = 0; e < 4; ++e) { v0[e] = gelu_tanh(v0[e]); v1[e] = gelu_tanh(v1[e]); }
                        }
                        if (sq) {
#pragma unroll
                            for (int e = 0; e < 4; ++e) { float a = fmaxf(v0[e], 0.f), b = fmaxf(v1[e], 0.f); v0[e] = a * a; v1[e] = b * b; }
                        }
                        u32x4 w; w.x = pk_bf16(v0[0], v0[1]); w.y = pk_bf16(v0[2], v0[3]); w.z = pk_bf16(v1[0], v1[1]); w.w = pk_bf16(v1[2], v1[3]);
                        *(u32x4*)(rowp + (sq ? bj * 2 * 16384 : bj * 128)) = w;
                    }
                }
        } else if (mode == EM_Q) {
#pragma unroll
            for (int bj = 0; bj < 2; ++bj) {
                const int c = col0 + bj * 128;
                const int j0 = c % 96;
                const bool rope_cols = j0 >= 64;
                const int jj0 = j0 - 64, ax = jj0 >> 4, fbase = (jj0 & 15) >> 1;
                float inv[4];
#pragma unroll
                for (int e = 0; e < 4; ++e) inv[e] = rope_inv(fbase + e);
#pragma unroll
                for (int ai = 0; ai < 2; ++ai)
#pragma unroll
                    for (int m = 0; m < 4; ++m) {
                        const int row = row0 + ai * 128 + m * 16;
                        f32x4 v0 = acc[ai][bj][m][0] * QSCALE, v1 = acc[ai][bj][m][1] * QSCALE;
                        if (rope_cols && row >= T_CTX) {
                            const int tt = (row - T_CTX) & 4095;
                            const float pos = (float)(ax == 0 ? (tt >> 6) : (tt & 63));
                            float s, cs, a, b;
                            sincos_rr(pos * inv[0], s, cs); a = v0[0]; b = v0[1]; v0[0] = a * cs - b * s; v0[1] = b * cs + a * s;
                            sincos_rr(pos * inv[1], s, cs); a = v0[2]; b = v0[3]; v0[2] = a * cs - b * s; v0[3] = b * cs + a * s;
                            sincos_rr(pos * inv[2], s, cs); a = v1[0]; b = v1[1]; v1[0] = a * cs - b * s; v1[1] = b * cs + a * s;
                            sincos_rr(pos * inv[3], s, cs); a = v1[2]; b = v1[3]; v1[2] = a * cs - b * s; v1[3] = b * cs + a * s;
                        }
                        u32x4 w; w.x = pk_bf16(v0[0], v0[1]); w.y = pk_bf16(v0[2], v0[3]); w.z = pk_bf16(v1[0], v1[1]); w.w = pk_bf16(v1[2], v1[3]);
                        *(u32x4*)(O + (size_t)row * 768 + c) = w;
                    }
            }
        } else if (mode == EM_K) {
            const int kr0 = u.pm * 256;
            size_t base; int L, l0;
            if (kr0 < T_CTX) { const int b = kr0 >> 8; L = 256; l0 = 0; base = (size_t)b * 8 * 256 * 96; }
            else { const int kk = kr0 - T_CTX, b = kk / LLAT; L = LLAT; l0 = kk - b * LLAT; base = KF_CTX + (size_t)b * 8 * LLAT * 96; }
#pragma unroll
            for (int bj = 0; bj < 2; ++bj) {
                const int c = col0 + bj * 128, h = c >> 6, j = c & 63;
#pragma unroll
                for (int ai = 0; ai < 2; ++ai)
#pragma unroll
                    for (int m = 0; m < 4; ++m) {
                        const int l = l0 + wr * 64 + fr + ai * 128 + m * 16;
                        const f32x4 v0 = acc[ai][bj][m][0], v1 = acc[ai][bj][m][1];
                        u32x4 w; w.x = pk_bf16(v0[0], v0[1]); w.y = pk_bf16(v0[2], v0[3]); w.z = pk_bf16(v1[0], v1[1]); w.w = pk_bf16(v1[2], v1[3]);
                        *(u32x4*)(O + base + ((size_t)h * L + l) * 96 + j) = w;
                    }
            }
            {
                const int tid = (wr * 4 + wc) * 64 + fq * 16 + fr;
#pragma unroll
                for (int q2 = 0; q2 < 2; ++q2) {
                    const int pr = tid + 512 * q2, r = pr & 255, h = u.pn * 4 + (pr >> 8);
                    const u32x4* src = (const u32x4*)(kpe + (size_t)(kr0 + r) * 32);
                    u32x4* dst = (u32x4*)(O + base + ((size_t)h * L + l0 + r) * 96 + 64);
                    const u32x4 c0 = src[0], c1 = src[1], c2 = src[2], c3 = src[3];
                    dst[0] = c0; dst[1] = c1; dst[2] = c2; dst[3] = c3;
                }
            }
        } else if (mode == EM_VT) {
            const int kr0 = u.pn * 256;
            size_t base; int L, l0;
            if (kr0 < T_CTX) { const int b = kr0 >> 8; L = 256; l0 = 0; base = (size_t)b * 8 * 64 * 256; }
            else { const int kk = kr0 - T_CTX, b = kk / LLAT; L = LLAT; l0 = kk - b * LLAT; base = VT_CTX + (size_t)b * 8 * 64 * LLAT; }
#pragma unroll
            for (int ai = 0; ai < 2; ++ai)
#pragma unroll
                for (int m = 0; m < 4; ++m) {
                    const int f = row0 + ai * 128 + m * 16;
#pragma unroll
                    for (int bj = 0; bj < 2; ++bj) {
                        const int l = l0 + wc * 32 + 8 * fq + bj * 128;
                        const f32x4 v0 = acc[ai][bj][m][0], v1 = acc[ai][bj][m][1];
                        u32x4 w; w.x = pk_bf16(v0[0], v0[1]); w.y = pk_bf16(v0[2], v0[3]); w.z = pk_bf16(v1[0], v1[1]); w.w = pk_bf16(v1[2], v1[3]);
                        *(u32x4*)(O + base + (size_t)f * L + l) = w;
                    }
                }
        } else {
            typedef _Float16 h16x8_t __attribute__((ext_vector_type(8)));
            typedef float f32x8_t __attribute__((ext_vector_type(8)));
            _Float16* X = (_Float16*)O;
            const int b = cond_of_row(u.pm * 256);
            const float* gp = gate + (size_t)b * MODW;
#pragma unroll
            for (int bj = 0; bj < 2; ++bj) {
                const int c = col0 + bj * 128;
                f32x4 g0 = *(const f32x4*)(gp + c), g1 = *(const f32x4*)(gp + c + 4);
                if (cscale) { g0 = g0 * *(const f32x4*)(cscale + c); g1 = g1 * *(const f32x4*)(cscale + c + 4); }
                h16x8_t xv[2][4];
#pragma unroll
                for (int ai = 0; ai < 2; ++ai)
#pragma unroll
                    for (int m = 0; m < 4; ++m) {
                        if (ai == 1 && u.mh) continue;
                        const int row = row0 + (u.mh == 2 ? 128 : 0) + ai * 128 + m * 16;
                        xv[ai][m] = *(const h16x8_t*)(X + (size_t)row * D + c);
                    }
#pragma unroll
                for (int ai = 0; ai < 2; ++ai)
#pragma unroll
                    for (int m = 0; m < 4; ++m) {
                        if (ai == 1 && u.mh) continue;
                        const int row = row0 + (u.mh == 2 ? 128 : 0) + ai * 128 + m * 16;
                        const f32x4 a0 = acc[ai][bj][m][0] * g0, a1 = acc[ai][bj][m][1] * g1;
                        f32x8_t xf = __builtin_convertvector(xv[ai][m], f32x8_t);
                        xf[0] += a0[0]; xf[1] += a0[1]; xf[2] += a0[2]; xf[3] += a0[3]; xf[4] += a1[0]; xf[5] += a1[1]; xf[6] += a1[2]; xf[7] += a1[3];
                        *(h16x8_t*)(X + (size_t)row * D + c) = __builtin_convertvector(xf, h16x8_t);
                    }
            }
        }
    }
};

struct TDesc { const float* src; bf16_t* dst; int ld, K, N, perm, tiled; };
DI int tperm(int perm, int n) {
    if (perm == 0) return n;
    if (perm == 1) return n < 672 ? n : (n < 768 ? -1 : n - 96);
    if (perm == 2) { const int h = n / 96, j = n - h * 96; if (j < 64) return n; const int jj = j - 64, a = jj >> 4, r = jj & 15, f = r >> 1, pp = r & 1; return h * 96 + 64 + a * 16 + pp * 8 + f; }
    if (perm == 3) return (n >> 6) * 128 + (n & 63);
    return (n >> 6) * 128 + 64 + (n & 63);
}
DI bool tdesc_find(KP p, int tile, TDesc& d, int& local) {
    int t = tile;
#define TD_TRY(SRC, DST, LD, KK, NN, PERM) { const int cnt = ((KK) / 64) * ((NN) / 32); if (t < cnt) { d.src = (SRC); d.dst = (DST); d.ld = (LD); d.K = (KK); d.N = (NN); d.perm = (PERM) & 15; d.tiled = (PERM) >> 4; local = t; return true; } t -= cnt; }
    for (int i = 0; i < 4; ++i) TD_TRY(p->in[I_WFF1] + (size_t)i * 1024 * FF, (bf16_t*)(p->ws + WS_WFF1) + (size_t)i * FF * 1024, FF, 1024, FF, 0)
    for (int i = 0; i < 4; ++i) TD_TRY(p->in[I_WFF2] + (size_t)i * FF * 1024, (bf16_t*)(p->ws + WS_WFF2) + (size_t)i * 1024 * FF, 1024, FF, 1024, 16)
    for (int i = 0; i < 2; ++i) TD_TRY(p->in[I_WIN] + (size_t)i * 1024 * 1696, (bf16_t*)(p->ws + WS_WIN) + (size_t)i * NZ * 1024, 1696, 1024, NZ, 1)
    for (int i = 0; i < 2; ++i) TD_TRY(p->in[I_WOUT] + (size_t)i * 1024 * 1024, (bf16_t*)(p->ws + WS_WOUT) + (size_t)i * 1024 * 1024, 1024, 1024, 1024, 0)
    for (int i = 0; i < 2; ++i) TD_TRY(p->in[I_WQB] + (size_t)i * 384 * 768, (bf16_t*)(p->ws + WS_WQB) + (size_t)i * 768 * 384, 768, 384, 768, 2)
    for (int i = 0; i < 2; ++i) TD_TRY(p->in[I_WKVB] + (size_t)i * 256 * 1024, (bf16_t*)(p->ws + WS_WK) + (size_t)i * 512 * 256, 1024, 256, 512, 3)
    for (int i = 0; i < 2; ++i) TD_TRY(p->in[I_WKVB] + (size_t)i * 256 * 1024, (bf16_t*)(p->ws + WS_WV) + (size_t)i * 512 * 256, 1024, 256, 512, 4)
    for (int i = 0; i < 8; ++i) TD_TRY(p->in[I_WPOOL] + (size_t)i * 256 * 256, (bf16_t*)(p->ws + WS_WPOOL) + (size_t)i * 256 * 256, 256, 256, 256, 0)
#undef TD_TRY
    return false;
}
constexpr int N_TITEMS = 2 * 896 + 2 * 144 + 2 * 64 + 2 * 64 + 2 * 512 + 8 * 32 + 4 * 2048 + 4 * 2048;
constexpr int N_MODU = 4 * 48;

DI void prologue_phase(int tid_o, int bid_o, KP p, LAS unsigned char* lds) {
    const int tid = tid_o, wid = tid >> 6, lane = tid & 63;
    LAS float* lf = (LAS float*)lds;
    for (int u = bid_o; u < N_MODU; u += gridDim.x) {
        const int l = u / 48, cb = u % 48;
        LAS float* sl = lf;
        LAS float* red = lf + 5120;
        for (int idx = tid; idx < 5120; idx += 512) { const int r = idx >> 10, k = idx & 1023; const float c = r < 4 ? p->in[I_C][r * 1024 + k] : p->in[I_CCTX][k]; sl[idx] = c / (1.f + __expf(-c)); }
        __syncthreads();
        float a[5][2];
#pragma unroll
        for (int r = 0; r < 5; ++r) { a[r][0] = 0.f; a[r][1] = 0.f; }
        const float* wp = p->in[I_WMOD] + ((size_t)l * 1024 + wid * 128) * MODW + cb * 128 + lane * 2;
#pragma unroll 16
        for (int kk = 0; kk < 128; ++kk) {
            const f32x2 wv = __builtin_nontemporal_load((const f32x2*)(wp + (size_t)kk * MODW));
#pragma unroll
            for (int r = 0; r < 5; ++r) { const float s = sl[r * 1024 + wid * 128 + kk]; a[r][0] += s * wv.x; a[r][1] += s * wv.y; }
        }
#pragma unroll
        for (int r = 0; r < 5; ++r) { red[(wid * 5 + r) * 128 + lane * 2] = a[r][0]; red[(wid * 5 + r) * 128 + lane * 2 + 1] = a[r][1]; }
        __syncthreads();
        for (int idx = tid; idx < 640; idx += 512) {
            const int r = idx >> 7, c = idx & 127; float s = p->in[I_BMOD][l * MODW + cb * 128 + c];
#pragma unroll
            for (int w = 0; w < 8; ++w) s += red[(w * 5 + r) * 128 + c];
            ((float*)(p->ws + WS_MOD))[(size_t)(l * 5 + r) * MODW + cb * 128 + c] = s;
        }
        __syncthreads();
    }
    for (int idx = bid_o * 512 + tid; idx < 32768; idx += gridDim.x * 512) {
        const int e0 = idx * 8;
        const f32x4 a = *(const f32x4*)(p->in[I_WSP] + e0), b = *(const f32x4*)(p->in[I_WSP] + e0 + 4);
        u32x4 w; w.x = pk_bf16(a[0], a[1]); w.y = pk_bf16(a[2], a[3]); w.z = pk_bf16(b[0], b[1]); w.w = pk_bf16(b[2], b[3]);
        *(u32x4*)((bf16_t*)(p->ws + WS_WSP) + e0) = w;
    }
    LAS float* sc = (LAS float*)(lds + 40960 + wid * 8448);
    const int G = gridDim.x;
    const bool lowb = bid_o < N_MODU && G > N_MODU;
    const int pool0 = G > N_MODU ? (N_TITEMS / 32) * 21 : N_TITEMS;
    const int it_begin = lowb ? bid_o * 8 + wid : (G > N_MODU ? pool0 + (bid_o - N_MODU) * 8 + wid : bid_o * 8 + wid);
    const int it_end = lowb ? pool0 : N_TITEMS;
    const int it_step = lowb ? N_MODU * 8 : (G > N_MODU ? (G - N_MODU) * 8 : G * 8);
    for (int it = it_begin; it < it_end; it += it_step) {
        TDesc d; int local;
        if (!tdesc_find(p, it, d, local)) continue;
        const int tiles_n = d.N / 32, tn = local % tiles_n, tk = local / tiles_n, n0 = tn * 32, k0 = tk * 64;
        { const int c = lane & 31, kh = lane >> 5; const int scol = tperm(d.perm, n0 + c);
            const float* sp = d.src + (size_t)(k0 + kh * 32) * d.ld + (scol >= 0 ? scol : 0);
            float v[32];
#pragma unroll
            for (int j = 0; j < 32; ++j) v[j] = scol >= 0 ? __builtin_nontemporal_load(sp + (size_t)j * d.ld) : 0.f;
#pragma unroll
            for (int j = 0; j < 32; ++j) sc[(kh * 32 + j) * 33 + c] = v[j]; }
        { const int ch = lane & 7, n = lane >> 3;
#pragma unroll
            for (int j4 = 0; j4 < 4; ++j4) { const int nn = n + 8 * j4; const LAS float* q = sc + (8 * ch) * 33 + nn;
                u32x4 o; o.x = pk_bf16(q[0 * 33], q[1 * 33]); o.y = pk_bf16(q[2 * 33], q[3 * 33]); o.z = pk_bf16(q[4 * 33], q[5 * 33]); o.w = pk_bf16(q[6 * 33], q[7 * 33]);
                bf16_t* dp = d.tiled ? d.dst + ((size_t)((n0 + nn) >> 8) * (d.K / 64) + tk) * 16384 + (size_t)((n0 + nn) & 255) * 64 + 8 * ch : d.dst + (size_t)(n0 + nn) * d.K + k0 + 8 * ch;
                *(u32x4*)dp = o; } }
    }
}

typedef _Float16 h16x4 __attribute__((ext_vector_type(4)));
DI void norm_phase(int tid_o, int bid_o, KP p, int layer, int which, bool first, bool final_) {
    const int wid = tid_o >> 6, lane = tid_o & 63;
    const float* gw = final_ ? p->in[I_FG] : (which == 0 ? p->in[I_N1G] : p->in[I_N2G]) + layer * D;
    bf16_t* H = (bf16_t*)(p->ws + WS_DELTA);
    _Float16* X16 = (_Float16*)(p->ws + WS_H);
    constexpr int NR = 4;
    for (int row0 = (bid_o * 8 + wid) * NR; row0 < T; row0 += gridDim.x * 8 * NR) {
        f32x4 v[NR][4];
        if (first) {
#pragma unroll
            for (int r = 0; r < NR; ++r) {
                const int row = row0 + r;
                const float* xr = row < T_CTX ? p->in[I_XP] + (size_t)row * D : p->in[I_XS] + (size_t)(row - T_CTX) * D;
#pragma unroll
                for (int j = 0; j < 4; ++j) v[r][j] = *(const f32x4*)(xr + j * 256 + lane * 4);
            }
        } else {
#pragma unroll
            for (int r = 0; r < NR; ++r)
#pragma unroll
                for (int j = 0; j < 4; ++j) v[r][j] = __builtin_convertvector(*(const h16x4*)(X16 + (size_t)(row0 + r) * D + j * 256 + lane * 4), f32x4);
        }
        float ss[NR];
#pragma unroll
        for (int r = 0; r < NR; ++r) {
            ss[r] = 0.f;
#pragma unroll
            for (int j = 0; j < 4; ++j) ss[r] += v[r][j][0] * v[r][j][0] + v[r][j][1] * v[r][j][1] + v[r][j][2] * v[r][j][2] + v[r][j][3] * v[r][j][3];
        }
#pragma unroll
        for (int o = 32; o; o >>= 1)
#pragma unroll
            for (int r = 0; r < NR; ++r) ss[r] += __shfl_xor(ss[r], o);
        float rs[NR];
#pragma unroll
        for (int r = 0; r < NR; ++r) rs[r] = rsqrtf(ss[r] * (1.f / D) + EPS);
        if (final_) {
#pragma unroll
            for (int j = 0; j < 4; ++j) {
                const int c = j * 256 + lane * 4; const f32x4 g4 = *(const f32x4*)(gw + c);
#pragma unroll
                for (int r = 0; r < NR; ++r) *(f32x4*)(p->out + (size_t)(row0 + r) * D + c) = v[r][j] * rs[r] * g4;
            }
        } else {
            if (first) {
#pragma unroll
                for (int r = 0; r < NR; ++r)
#pragma unroll
                    for (int j = 0; j < 4; ++j) *(h16x4*)(X16 + (size_t)(row0 + r) * D + j * 256 + lane * 4) = __builtin_convertvector(v[r][j], h16x4);
            }
            const float* md = (const float*)(p->ws + WS_MOD) + (size_t)(layer * 5 + cond_of_row(row0)) * MODW + (which ? 3 * D : 0);
#pragma unroll
            for (int j = 0; j < 4; ++j) {
                const int c = j * 256 + lane * 4;
                const f32x4 g4 = *(const f32x4*)(gw + c), sh = *(const f32x4*)(md + c), sc = *(const f32x4*)(md + D + c);
                const f32x4 gm = g4 * (sc + 1.f);
#pragma unroll
                for (int r = 0; r < NR; ++r) {
                    const f32x4 y = v[r][j] * rs[r] * gm + sh;
                    u32x2 w; w.x = pk_bf16(y[0], y[1]); w.y = pk_bf16(y[2], y[3]);
                    *(u32x2*)(H + (size_t)(row0 + r) * D + c) = w;
                }
            }
        }
    }
}

DI void rowop_phase(int tid_o, int bid_o, KP p, int i) {
    const int wid = tid_o >> 6, lane = tid_o & 63;
    const bf16_t* Z = (const bf16_t*)(p->ws + WS_Z);
    bf16_t* QN = (bf16_t*)(p->ws + WS_QN); bf16_t* CKV = (bf16_t*)(p->ws + WS_CKV); bf16_t* KPE = (bf16_t*)(p->ws + WS_KPE); bf16_t* VN = (bf16_t*)(p->ws + WS_VN);
    const float* qag = p->in[I_QAG] + i * 384; const float* kvg = p->in[I_KVAG] + i * 256; const float* vg = p->in[I_VG] + i * 512;
    constexpr int NR = 4;
    for (int it0 = (bid_o * 8 + wid) * NR; it0 < T; it0 += gridDim.x * 8 * NR) {
        u32x2 zz[NR][5];
#pragma unroll
        for (int r = 0; r < NR; ++r) {
            const bf16_t* zr = Z + (size_t)(it0 + r) * NZ;
            zz[r][0] = *(const u32x2*)(zr + 4 * lane); zz[r][1] = *(const u32x2*)(zr + 4 * (64 + lane)); zz[r][2] = *(const u32x2*)(zr + 4 * (128 + (lane < 40 ? lane : 0)));
            zz[r][3] = *(const u32x2*)(zr + 4 * (320 + lane)); zz[r][4] = *(const u32x2*)(zr + 4 * (384 + lane));
        }
#pragma unroll
        for (int r = 0; r < NR; ++r) {
            const int row = it0 + r;
            const u32x2 z0 = zz[r][0], z1 = zz[r][1], z2 = zz[r][2], z5 = zz[r][3], z6 = zz[r][4];
            float a0[4] = {bf_lo(z0.x), bf_hi(z0.x), bf_lo(z0.y), bf_hi(z0.y)};
            float a1[4] = {bf_lo(z1.x), bf_hi(z1.x), bf_lo(z1.y), bf_hi(z1.y)};
            float a2[4] = {bf_lo(z2.x), bf_hi(z2.x), bf_lo(z2.y), bf_hi(z2.y)};
            float a5[4] = {bf_lo(z5.x), bf_hi(z5.x), bf_lo(z5.y), bf_hi(z5.y)};
            float a6[4] = {bf_lo(z6.x), bf_hi(z6.x), bf_lo(z6.y), bf_hi(z6.y)};
            const float s0 = a0[0] * a0[0] + a0[1] * a0[1] + a0[2] * a0[2] + a0[3] * a0[3];
            const float s1 = a1[0] * a1[0] + a1[1] * a1[1] + a1[2] * a1[2] + a1[3] * a1[3];
            const float s2 = a2[0] * a2[0] + a2[1] * a2[1] + a2[2] * a2[2] + a2[3] * a2[3];
            const float s5 = a5[0] * a5[0] + a5[1] * a5[1] + a5[2] * a5[2] + a5[3] * a5[3] + a6[0] * a6[0] + a6[1] * a6[1] + a6[2] * a6[2] + a6[3] * a6[3];
            const float ssq = wave_sum(s0 + (lane < 32 ? s1 : 0.f));
            const float sskv = wave_sum((lane >= 32 ? s1 : 0.f) + (lane < 32 ? s2 : 0.f));
            const float ssv = wave_sum(s5);
            const float rq = rsqrtf(ssq * (1.f / 384.f) + EPS), rkv = rsqrtf(sskv * (1.f / 256.f) + EPS), rv = rsqrtf(ssv * (1.f / 512.f) + EPS);
            int krow, l, L; size_t kfbase; bool lat = row >= T_CTX; int b, tt;
            if (!lat) { b = row >> 8; tt = row & 255; krow = row; l = tt; L = 256; kfbase = (size_t)b * 8 * 256 * 96; }
            else { const int r2 = row - T_CTX; b = r2 >> 12; tt = r2 & 4095; krow = T_CTX + b * LLAT + 512 + tt; l = 512 + tt; L = LLAT; kfbase = KF_CTX + (size_t)b * 8 * LLAT * 96; }
            { const int c = 4 * lane; const f32x4 g = *(const f32x4*)(qag + c); u32x2 w; w.x = pk_bf16(a0[0] * rq * g[0], a0[1] * rq * g[1]); w.y = pk_bf16(a0[2] * rq * g[2], a0[3] * rq * g[3]); *(u32x2*)(QN + (size_t)row * 384 + c) = w; }
            if (lane < 32) { const int c = 256 + 4 * lane; const f32x4 g = *(const f32x4*)(qag + c); u32x2 w; w.x = pk_bf16(a1[0] * rq * g[0], a1[1] * rq * g[1]); w.y = pk_bf16(a1[2] * rq * g[2], a1[3] * rq * g[3]); *(u32x2*)(QN + (size_t)row * 384 + c) = w; }
            {
                const bool hi = lane >= 32; const int c = hi ? 4 * (lane - 32) : 128 + 4 * lane;
                const f32x4 g = *(const f32x4*)(kvg + c);
                f32x4 y;
#pragma unroll
                for (int e = 0; e < 4; ++e) y[e] = (hi ? a1[e] : a2[e]) * rkv * g[e];
                u32x2 w; w.x = pk_bf16(y[0], y[1]); w.y = pk_bf16(y[2], y[3]);
                *(u32x2*)(CKV + (size_t)krow * 256 + c) = w;
                if (!lat) *(f32x4*)(p->out + OUT_CKV + ((size_t)(b * 2 + i) * 256 + tt) * 256 + c) = y;
            }
            {
                const int j0 = ((lane - 32) & 7) * 4;
                float o[4], pr[4], op[4];
#pragma unroll
                for (int e = 0; e < 4; ++e) pr[e] = __shfl_xor(a2[e], 2);
                const int ax = j0 >> 4, pbit = (j0 >> 3) & 1, f0 = j0 & 7;
                if (lat) {
                    const float pos = (float)(ax == 0 ? (tt >> 6) : (tt & 63));
#pragma unroll
                    for (int e = 0; e < 4; ++e) { float s, cs; sincos_rr(pos * rope_inv(f0 + e), s, cs); o[e] = pbit ? (a2[e] * cs + pr[e] * s) : (a2[e] * cs - pr[e] * s); }
                } else {
#pragma unroll
                    for (int e = 0; e < 4; ++e) o[e] = a2[e];
                }
#pragma unroll
                for (int e = 0; e < 4; ++e) op[e] = __shfl_xor(o[e], 2);
                if (lane >= 32 && lane < 40) {
                    if (!lat) *(f32x4*)(p->out + OUT_KPE + ((size_t)(b * 2 + i) * 256 + tt) * 32 + j0) = (f32x4){a2[0], a2[1], a2[2], a2[3]};
                    u32x2 w;
                    if (pbit == 0) { w.x = pk_bf16(o[0], op[0]); w.y = pk_bf16(o[1], op[1]); }
                    else { w.x = pk_bf16(op[2], o[2]); w.y = pk_bf16(op[3], o[3]); }
                    *(u32x2*)(KPE + (size_t)krow * 32 + ax * 16 + 2 * (f0 + 2 * pbit)) = w;
                }
            }
            { const int c = 4 * lane; const f32x4 g = *(const f32x4*)(vg + c); u32x2 w; w.x = pk_bf16(a5[0] * rv * g[0], a5[1] * rv * g[1]); w.y = pk_bf16(a5[2] * rv * g[2], a5[3] * rv * g[3]); *(u32x2*)(VN + (size_t)row * 512 + c) = w; }
            { const int c = 256 + 4 * lane; const f32x4 g = *(const f32x4*)(vg + c); u32x2 w; w.x = pk_bf16(a6[0] * rv * g[0], a6[1] * rv * g[1]); w.y = pk_bf16(a6[2] * rv * g[2], a6[3] * rv * g[3]); *(u32x2*)(VN + (size_t)row * 512 + c) = w; }
        }
    }
    for (int it = bid_o * 8 + wid; it < 2048; it += gridDim.x * 8) {
        {
            const int r = it, b = r >> 9, pp = r & 511;
            const float* src = p->in[I_CCKV] + ((size_t)(b * 2 + i) * 512 + pp) * 256;
            const f32x4 v = *(const f32x4*)(src + 4 * lane);
            u32x2 w; w.x = pk_bf16(v[0], v[1]); w.y = pk_bf16(v[2], v[3]);
            *(u32x2*)(CKV + (size_t)(T_CTX + b * LLAT + pp) * 256 + 4 * lane) = w;
            {
                const f32x4 k = *(const f32x4*)(p->in[I_CKPE] + ((size_t)(b * 2 + i) * 512 + pp) * 32 + 4 * (lane & 7));
                const int j0 = 4 * (lane & 7), ax = j0 >> 4, pbit = (j0 >> 3) & 1, f0 = j0 & 7;
                float op[4];
#pragma unroll
                for (int e = 0; e < 4; ++e) op[e] = __shfl_xor(k[e], 2);
                if (lane < 8) {
                    u32x2 w;
                    if (pbit == 0) { w.x = pk_bf16(k[0], op[0]); w.y = pk_bf16(k[1], op[1]); }
                    else { w.x = pk_bf16(op[2], k[2]); w.y = pk_bf16(op[3], k[3]); }
                    *(u32x2*)(KPE + (size_t)(T_CTX + b * LLAT + pp) * 32 + ax * 16 + 2 * (f0 + 2 * pbit)) = w;
                }
            }
        }
    }
}

constexpr int AK_ROW = 208, AV_ROW = 136, AK_BUF = 64 * AK_ROW, AV_BUF = 64 * AV_ROW, AV_OFF = 2 * AK_BUF;
#define MFMA32(a, b, c) __builtin_amdgcn_mfma_f32_32x32x16_bf16((a), (b), (c), 0, 0, 0)
DI void attn_unit(int tid_o, LAS unsigned char* lds, const bf16_t* Qb, const bf16_t* Kb, const bf16_t* Vb, int L, bf16_t* Ob) {
    const int tid = tid_o, wid = tid >> 6, lane = tid & 63, r32 = lane & 31, hh = lane >> 5;
    bf16x8 qf[6];
    { const bf16_t* qp = Qb + (size_t)(wid * 32 + r32) * 768 + hh * 8;
#pragma unroll
        for (int s = 0; s < 6; ++s) qf[s] = *(const bf16x8*)(qp + s * 16); }
    const bool lo256 = tid < 256;
    const int c1 = tid + 512;
    const bf16_t* g0 = Kb; const unsigned go0 = (tid / 12) * 96 + (tid % 12) * 8;
    const unsigned l0 = (tid / 12) * AK_ROW + (tid % 12) * 16;
    const bf16_t* g1 = lo256 ? Kb : Vb; const unsigned go1 = lo256 ? (c1 / 12) * 96 + (c1 % 12) * 8 : (unsigned)((tid - 256) >> 3) * L + ((tid - 256) & 7) * 8;
    const unsigned l1 = lo256 ? (c1 / 12) * AK_ROW + (c1 % 12) * 16 : AV_OFF + ((tid - 256) >> 3) * AV_ROW + ((tid - 256) & 7) * 16;
    const bf16_t* g2 = Vb; const unsigned go2 = (unsigned)((tid + 256) >> 3) * L + ((tid + 256) & 7) * 8;
    const unsigned l2 = AV_OFF + ((tid + 256) >> 3) * AV_ROW + ((tid + 256) & 7) * 16;
    const int st1 = lo256 ? 64 * 96 : 64;
    const int nt = L / 64;
    u32x4 s0r, s1r, s2r;
    s0r = *(const u32x4*)(g0 + go0); s1r = *(const u32x4*)(g1 + go1); if (lo256) s2r = *(const u32x4*)(g2 + go2);
    {
        *(LAS u32x4*)(lds + l0) = s0r;
        if (lo256) { *(LAS u32x4*)(lds + l1) = s1r; *(LAS u32x2*)(lds + l2) = (u32x2){s2r.x, s2r.y}; *(LAS u32x2*)(lds + l2 + 8) = (u32x2){s2r.z, s2r.w}; }
        else { *(LAS u32x2*)(lds + l1) = (u32x2){s1r.x, s1r.y}; *(LAS u32x2*)(lds + l1 + 8) = (u32x2){s1r.z, s1r.w}; }
    }
    __syncthreads();
    f32x16 o0, o1;
#pragma unroll
    for (int e = 0; e < 16; ++e) { o0[e] = 0.f; o1[e] = 0.f; }
    float mrun = -INFINITY, lsum = 0.f;
    if (wid >= 4) __builtin_amdgcn_s_setprio(1);
    for (int kt = 0; kt < nt; ++kt) {
        const int buf = kt & 1;
        const bool pre = kt + 1 < nt;
        if (pre) {
            s0r = *(const u32x4*)(g0 + (go0 + (unsigned)(kt + 1) * 64 * 96)); s1r = *(const u32x4*)(g1 + (go1 + (unsigned)(kt + 1) * st1)); if (lo256) s2r = *(const u32x4*)(g2 + (go2 + (unsigned)(kt + 1) * 64));
        }
        f32x16 sa, sb;
#pragma unroll
        for (int e = 0; e < 16; ++e) { sa[e] = 0.f; sb[e] = 0.f; }
        const LAS unsigned char* kb = lds + buf * AK_BUF + r32 * AK_ROW + hh * 16;
        __builtin_amdgcn_s_setprio(1);
#pragma unroll
        for (int s = 0; s < 6; ++s) {
            const bf16x8 a0 = *(const LAS bf16x8*)(kb + s * 32), a1 = *(const LAS bf16x8*)(kb + 32 * AK_ROW + s * 32);
            sa = MFMA32(a0, qf[s], sa); sb = MFMA32(a1, qf[s], sb);
        }
        __builtin_amdgcn_s_setprio(0);
        __builtin_amdgcn_sched_barrier(0);
        float mx = fmaxf(sa[0], sb[0]);
#pragma unroll
        for (int e = 1; e < 16; ++e) mx = fmaxf(fmaxf(mx, sa[e]), sb[e]);
        mx = fmaxf(mx, __shfl_xor(mx, 32));
        if (__builtin_amdgcn_ballot_w64(mx - mrun > 8.f) != 0ull) {
            const float mn = fmaxf(mrun, mx);
            const float alpha = __builtin_amdgcn_exp2f(mrun - mn);
            lsum *= alpha; o0 = o0 * alpha; o1 = o1 * alpha;
            mrun = mn;
        }
        float ps = 0.f;
#pragma unroll
        for (int e = 0; e < 16; ++e) { sa[e] = __builtin_amdgcn_exp2f(sa[e] - mrun); ps += sa[e]; }
#pragma unroll
        for (int e = 0; e < 16; ++e) { sb[e] = __builtin_amdgcn_exp2f(sb[e] - mrun); ps += sb[e]; }
        lsum += ps;
        __builtin_amdgcn_sched_barrier(0);
        const LAS unsigned char* vb = lds + AV_OFF + buf * AV_BUF + r32 * AV_ROW + hh * 8;
#pragma unroll
        for (int kb2 = 0; kb2 < 2; ++kb2)
#pragma unroll
            for (int s = 0; s < 2; ++s) {
                u32x4 pw;
                if (kb2 == 0) { pw.x = pk_bf16(sa[8 * s + 0], sa[8 * s + 1]); pw.y = pk_bf16(sa[8 * s + 2], sa[8 * s + 3]); pw.z = pk_bf16(sa[8 * s + 4], sa[8 * s + 5]); pw.w = pk_bf16(sa[8 * s + 6], sa[8 * s + 7]); }
                else { pw.x = pk_bf16(sb[8 * s + 0], sb[8 * s + 1]); pw.y = pk_bf16(sb[8 * s + 2], sb[8 * s + 3]); pw.z = pk_bf16(sb[8 * s + 4], sb[8 * s + 5]); pw.w = pk_bf16(sb[8 * s + 6], sb[8 * s + 7]); }
                const bf16x8 pb = __builtin_bit_cast(bf16x8, pw);
                const int ko = (kb2 * 32 + 16 * s) * 2;
                const u32x2 v0l = *(const LAS u32x2*)(vb + ko), v0h = *(const LAS u32x2*)(vb + ko + 16);
                const u32x2 v1l = *(const LAS u32x2*)(vb + 32 * AV_ROW + ko), v1h = *(const LAS u32x2*)(vb + 32 * AV_ROW + ko + 16);
                const bf16x8 va0 = __builtin_bit_cast(bf16x8, (u32x4){v0l.x, v0l.y, v0h.x, v0h.y});
                const bf16x8 va1 = __builtin_bit_cast(bf16x8, (u32x4){v1l.x, v1l.y, v1h.x, v1h.y});
                o0 = MFMA32(va0, pb, o0); o1 = MFMA32(va1, pb, o1);
            }
        if (pre) {
            const unsigned bo = (buf ^ 1) * AK_BUF, vo = (buf ^ 1) * AV_BUF;
            *(LAS u32x4*)(lds + bo + l0) = s0r;
            if (lo256) { *(LAS u32x4*)(lds + bo + l1) = s1r; *(LAS u32x2*)(lds + vo + l2) = (u32x2){s2r.x, s2r.y}; *(LAS u32x2*)(lds + vo + l2 + 8) = (u32x2){s2r.z, s2r.w}; }
            else { *(LAS u32x2*)(lds + vo + l1) = (u32x2){s1r.x, s1r.y}; *(LAS u32x2*)(lds + vo + l1 + 8) = (u32x2){s1r.z, s1r.w}; }
        }
        __syncthreads();
    }
    __builtin_amdgcn_s_setprio(0);
    const float lt = lsum + __shfl_xor(lsum, 32);
    const float inv = 1.f / lt;
    bf16_t* op = Ob + (size_t)(wid * 32 + r32) * D + 4 * hh;
#pragma unroll
    for (int g = 0; g < 4; ++g) {
        u32x2 w0; w0.x = pk_bf16(o0[4 * g] * inv, o0[4 * g + 1] * inv); w0.y = pk_bf16(o0[4 * g + 2] * inv, o0[4 * g + 3] * inv);
        u32x2 w1; w1.x = pk_bf16(o1[4 * g] * inv, o1[4 * g + 1] * inv); w1.y = pk_bf16(o1[4 * g + 2] * inv, o1[4 * g + 3] * inv);
        *(u32x2*)(op + 8 * g) = w0; *(u32x2*)(op + 32 + 8 * g) = w1;
    }
}
DI void attn_phase(int tid_o, int bid_o, KP p, LAS unsigned char* lds) {
    const bf16_t* Q = (const bf16_t*)(p->ws + WS_Q); const bf16_t* KF = (const bf16_t*)(p->ws + WS_KF); const bf16_t* VT = (const bf16_t*)(p->ws + WS_VT);
    bf16_t* MIX = (bf16_t*)((unsigned char*)p->out);
    for (int u = bid_o; u < 768; u += gridDim.x) {
        if (u < 512) {
            const int x = u & 7, r = u >> 3, bh = x * 4 + (r >> 4), qb = r & 15, b = bh >> 3, h = bh & 7;
            const int tok0 = T_CTX + b * 4096 + qb * 256;
            attn_unit(tid_o, lds, Q + (size_t)tok0 * 768 + h * 96, KF + KF_CTX + (size_t)(b * 8 + h) * LLAT * 96, VT + VT_CTX + (size_t)(b * 8 + h) * 64 * LLAT, LLAT, MIX + (size_t)tok0 * D + h * 64);
        } else {
            const int bh = u - 512, b = bh >> 3, h = bh & 7;
            const int tok0 = b * 256;
            attn_unit(tid_o, lds, Q + (size_t)tok0 * 768 + h * 96, KF + (size_t)(b * 8 + h) * 256 * 96, VT + (size_t)(b * 8 + h) * 64 * 256, 256, MIX + (size_t)tok0 * D + h * 64);
        }
    }
}

DI void spatial_phase(int tid_o, int bid_o, KP p, LAS unsigned char* lds, int i) {
    const int tid = tid_o, wid = tid >> 6, lane = tid & 63, fr = lane & 15, fq = lane >> 4;
    const bf16_t* VN = (const bf16_t*)(p->ws + WS_VN); const bf16_t* Z = (const bf16_t*)(p->ws + WS_Z); const bf16_t* WSP = (const bf16_t*)(p->ws + WS_WSP) + (size_t)i * 8 * 128 * 128;
    bf16_t* MIX = (bf16_t*)((unsigned char*)p->out);
    const float* bs = p->in[I_BSP] + i * 8 * 128;
    const int NU = (T / 128) * 8;
    u32x4 vv[2];
    if (bid_o < NU) {
        const int chunk = bid_o >> 3, g = bid_o & 7, tok0 = chunk * 128;
#pragma unroll
        for (int k = 0; k < 2; ++k) { const int id = tid + 512 * k, q = id >> 3, c0 = (id & 7) * 8; vv[k] = *(const u32x4*)(VN + (size_t)(tok0 + q) * 512 + g * 64 + c0); }
    }
    for (int u = bid_o; u < NU; u += gridDim.x) {
        const int chunk = u >> 3, g = u & 7, tok0 = chunk * 128;
#pragma unroll
        for (int k = 0; k < 2; ++k) {
            const int id = tid + 512 * k, q = id >> 3, c0 = (id & 7) * 8;
            const u32x4 v = vv[k];
            LAS bf16_t* dst = (LAS bf16_t*)(lds + c0 * 272 + q * 2);
            dst[0 * 136] = (bf16_t)(v.x & 0xffff); dst[1 * 136] = (bf16_t)(v.x >> 16); dst[2 * 136] = (bf16_t)(v.y & 0xffff); dst[3 * 136] = (bf16_t)(v.y >> 16);
            dst[4 * 136] = (bf16_t)(v.z & 0xffff); dst[5 * 136] = (bf16_t)(v.z >> 16); dst[6 * 136] = (bf16_t)(v.w & 0xffff); dst[7 * 136] = (bf16_t)(v.w >> 16);
        }
        __syncthreads();
        { const int un = u + gridDim.x;
          if (un < NU) { const int chn = un >> 3, gn = un & 7, tk0 = chn * 128;
#pragma unroll
            for (int k = 0; k < 2; ++k) { const int id = tid + 512 * k, q = id >> 3, c0 = (id & 7) * 8; vv[k] = *(const u32x4*)(VN + (size_t)(tk0 + q) * 512 + gn * 64 + c0); } } }
        const int prow = 16 * wid + fr, tok = tok0 + prow;
        u32x2 uu[4];
#pragma unroll
        for (int n = 0; n < 4; ++n) uu[n] = *(const u32x2*)(Z + (size_t)tok * NZ + 768 + g * 64 + 16 * n + 4 * fq);
        const float bias = bs[g * 128 + prow];
        bf16x8 wa[4];
#pragma unroll
        for (int k = 0; k < 4; ++k) wa[k] = *(const bf16x8*)(WSP + ((size_t)g * 128 + 16 * wid + fr) * 128 + 32 * k + fq * 8);
        f32x4 acc[4];
#pragma unroll
        for (int n = 0; n < 4; ++n) acc[n] = (f32x4){0.f, 0.f, 0.f, 0.f};
#pragma unroll
        for (int k = 0; k < 4; ++k) {
#pragma unroll
            for (int n = 0; n < 4; ++n) {
                const bf16x8 b = *(const LAS bf16x8*)(lds + (16 * n + fr) * 272 + (32 * k + fq * 8) * 2);
                acc[n] = __builtin_amdgcn_mfma_f32_16x16x32_bf16(b, wa[k], acc[n], 0, 0, 0);
            }
        }
#pragma unroll
        for (int n = 0; n < 4; ++n) {
            const int ch = g * 64 + 16 * n + 4 * fq;
            u32x2 w; w.x = pk_bf16(bf_lo(uu[n].x) * (acc[n][0] + bias), bf_hi(uu[n].x) * (acc[n][1] + bias)); w.y = pk_bf16(bf_lo(uu[n].y) * (acc[n][2] + bias), bf_hi(uu[n].y) * (acc[n][3] + bias));
            *(u32x2*)(MIX + (size_t)tok * D + 512 + ch) = w;
        }
        __syncthreads();
    }
}

template <int HW>
DI void pd_item(const bf16_t* hb, bf16_t* pb, int tt0, int len) {
    constexpr int NRW = 8 + 2 * HW;
    u32x4 rw[NRW];
#pragma unroll
    for (int k = 0; k < NRW; ++k) {
        const int t2 = tt0 - HW + k;
        rw[k] = (t2 >= 0 && t2 < len) ? *(const u32x4*)(hb + (size_t)t2 * D) : (u32x4){0u, 0u, 0u, 0u};
    }
    float sum[8];
#pragma unroll
    for (int e = 0; e < 8; ++e) sum[e] = 0.f;
#pragma unroll
    for (int k = 0; k < 2 * HW; ++k) {
        sum[0] += bf_lo(rw[k].x); sum[1] += bf_hi(rw[k].x); sum[2] += bf_lo(rw[k].y); sum[3] += bf_hi(rw[k].y); sum[4] += bf_lo(rw[k].z); sum[5] += bf_hi(rw[k].z); sum[6] += bf_lo(rw[k].w); sum[7] += bf_hi(rw[k].w);
    }
#pragma unroll
    for (int j = 0; j < 8; ++j) {
        const int tt = tt0 + j, lo = max(tt - HW, 0), hi = min(tt + HW, len);
        const float ic = 1.f / (float)(hi - lo);
        const u32x4 v = rw[j + HW];
        u32x4 w;
        w.x = pk_bf16(sum[0] * ic - bf_lo(v.x), sum[1] * ic - bf_hi(v.x)); w.y = pk_bf16(sum[2] * ic - bf_lo(v.y), sum[3] * ic - bf_hi(v.y));
        w.z = pk_bf16(sum[4] * ic - bf_lo(v.z), sum[5] * ic - bf_hi(v.z)); w.w = pk_bf16(sum[6] * ic - bf_lo(v.w), sum[7] * ic - bf_hi(v.w));
        *(u32x4*)(pb + (size_t)tt * D) = w;
        if (j < 7) {
            const u32x4 a = rw[j + 2 * HW], s2 = rw[j];
            sum[0] += bf_lo(a.x) - bf_lo(s2.x); sum[1] += bf_hi(a.x) - bf_hi(s2.x); sum[2] += bf_lo(a.y) - bf_lo(s2.y); sum[3] += bf_hi(a.y) - bf_hi(s2.y);
            sum[4] += bf_lo(a.z) - bf_lo(s2.z); sum[5] += bf_hi(a.z) - bf_hi(s2.z); sum[6] += bf_lo(a.w) - bf_lo(s2.w); sum[7] += bf_hi(a.w) - bf_hi(s2.w);
        }
    }
}
DI void pooldiff_phase(int tid_o, int bid_o, KP p) {
    const bf16_t* H = (const bf16_t*)(p->ws + WS_DELTA); bf16_t* PD = (bf16_t*)(p->ws + WS_PD);
    const int wid = tid_o >> 6, lane = tid_o & 63;
    for (int wi = bid_o * 8 + wid; wi < (T / 16) * 4; wi += gridDim.x * 8) {
        const int gi = wi & 3, tb = (wi >> 2) * 2 + (lane >> 5), c0 = gi * 256 + (lane & 31) * 8;
        const int tok0 = tb * 8;
        int s0, len;
        if (tok0 < T_CTX) { s0 = tok0 & ~255; len = 256; } else { s0 = T_CTX + ((tok0 - T_CTX) & ~4095); len = 4096; }
        const int tt0 = tok0 - s0;
        const bf16_t* hb = H + (size_t)s0 * D + c0; bf16_t* pb = PD + (size_t)s0 * D + c0;
        if (gi == 0) pd_item<1>(hb, pb, tt0, len);
        else if (gi == 1) pd_item<2>(hb, pb, tt0, len);
        else if (gi == 2) pd_item<4>(hb, pb, tt0, len);
        else pd_item<8>(hb, pb, tt0, len);
    }
}

DI void run_phase(int tid_o, int bid_o, KP p, LAS unsigned char* lds, int ph) {
    const float* MOD = (const float*)(p->ws + WS_MOD);

#ifndef DIS_PRO
    if (ph == 0) { prologue_phase(tid_o, bid_o, p, lds); return; }
#endif


#ifndef DIS_NORMF
    if (ph == 31) { norm_phase(tid_o, bid_o, p, 0, 0, false, true); return; }
#endif

    const int q = ph - 1, pair = q / 15, r = q % 15;
    const bool ab = r < 9;
    const int layer = pair * 2 + (ab ? 0 : 1), s = ab ? r : r - 9, i = pair;
    const int slot_n2 = ab ? 6 : 3;

#ifndef DIS_NORM
    if (s == 0) { norm_phase(tid_o, bid_o, p, layer, 0, layer == 0, false); return; }
    if (s == slot_n2) { norm_phase(tid_o, bid_o, p, layer, 1, false, false); return; }
#endif

    if (s == slot_n2 + 1) {
        pg8::Gemm g{(const bf16_t*)(p->ws + WS_DELTA), (const bf16_t*)(p->ws + WS_WFF1) + (size_t)layer * FF * 1024, 1024, 1024, 1024, 0, T / 256, FF / 256, 0, nullptr, nullptr, 0, 0, 0};
        Epi<EM_FF1> E{(bf16_t*)(p->ws + WS_FFH), nullptr, nullptr, nullptr, nullptr, nullptr, nullptr};

#ifndef DIS_FF1
        pg8::gemm_phase(tid_o, bid_o, lds, g, E);
#endif
        return;
    }
    if (s == slot_n2 + 2) {

        pg8::Gemm g{(const bf16_t*)(p->ws + WS_FFH), (const bf16_t*)(p->ws + WS_WFF2) + (size_t)layer * 1024 * FF, FF, FF, FF, 0, T / 256, 4, 0, nullptr, nullptr, 1, 1, 1};
        Epi<EM_RES> E{(bf16_t*)(p->ws + WS_H), nullptr, nullptr, nullptr, MOD + (size_t)layer * 5 * MODW + 5 * D, nullptr, nullptr};
#ifndef DIS_FF2
        pg8::gemm_phase(tid_o, bid_o, lds, g, E); return;
#else
        return;
#endif
    }
    if (ab) {
        if (s == 1) {
            pg8::Gemm g{(const bf16_t*)(p->ws + WS_DELTA), (const bf16_t*)(p->ws + WS_WIN) + (size_t)i * NZ * 1024, 1024, 1024, 1024, 0, T / 256, NZ / 256, 0, nullptr, nullptr, 0, 0, 0};
            Epi<EM_Z> E{(bf16_t*)(p->ws + WS_Z), nullptr, nullptr, nullptr, nullptr, nullptr, nullptr};
#ifndef DIS_ZIN
            pg8::gemm_phase(tid_o, bid_o, lds, g, E); return;
#else
            return;
#endif
        }
#ifndef DIS_ROWOP
        if (s == 2) { rowop_phase(tid_o, bid_o, p, i); return; }
#else
        if (s == 2) return;
#endif
        if (s == 3) {
            { pg8::Gemm g{(const bf16_t*)(p->ws + WS_QN), (const bf16_t*)(p->ws + WS_WQB) + (size_t)i * 768 * 384, 384, 384, 384, 0, T / 256, 3, 0, nullptr, nullptr, 0, 0, 0};
              Epi<EM_Q> E{(bf16_t*)(p->ws + WS_Q), nullptr, nullptr, nullptr, nullptr, nullptr, nullptr};
#ifndef DIS_Q
              pg8::gemm_phase(tid_o, bid_o, lds, g, E); }
#else
              }
#endif
            { pg8::Gemm g{(const bf16_t*)(p->ws + WS_CKV), (const bf16_t*)(p->ws + WS_WK) + (size_t)i * 512 * 256, 256, 256, 256, 0, KR / 256, 2, 224, nullptr, nullptr, 0, 0, 0};
              Epi<EM_K> E{(bf16_t*)(p->ws + WS_KF), nullptr, nullptr, nullptr, nullptr, nullptr, (const bf16_t*)(p->ws + WS_KPE)};
#ifndef DIS_K
              pg8::gemm_phase(tid_o, bid_o, lds, g, E); }
#else
              }
#endif
            { pg8::Gemm g{(const bf16_t*)(p->ws + WS_WV) + (size_t)i * 512 * 256, (const bf16_t*)(p->ws + WS_CKV), 256, 256, 256, 0, 2, KR / 256, 208, nullptr, nullptr, 0, 0, 0};
              Epi<EM_VT> E{(bf16_t*)(p->ws + WS_VT), nullptr, nullptr, nullptr, nullptr, nullptr, nullptr};
#ifndef DIS_V
              pg8::gemm_phase(tid_o, bid_o, lds, g, E); }
#else
              }
#endif
#ifndef DIS_SPAT
            spatial_phase(tid_o, bid_o, p, lds, i);
#else

#endif
            return;
        }
#ifndef DIS_ATTN
        if (s == 4) { attn_phase(tid_o, bid_o, p, lds); return; }
#else
        if (s == 4) return;
#endif
        if (s == 5) {
            pg8::Gemm g{(const bf16_t*)((unsigned char*)p->out), (const bf16_t*)(p->ws + WS_WOUT) + (size_t)i * 1024 * 1024, 1024, 1024, 1024, 0, T / 256, 4, 0, nullptr, nullptr, 0, 0, 1};
            Epi<EM_RES> E{(bf16_t*)(p->ws + WS_H), nullptr, nullptr, nullptr, MOD + (size_t)layer * 5 * MODW + 2 * D, nullptr, nullptr};
#ifndef DIS_OUT
            pg8::gemm_phase(tid_o, bid_o, lds, g, E); return;
#else
            return;
#endif
        }
    } else {
#ifndef DIS_PD
        if (s == 1) { pooldiff_phase(tid_o, bid_o, p); return; }
#else
        if (s == 1) return;
#endif
        if (s == 2) {
            pg8::Gemm g{(const bf16_t*)(p->ws + WS_PD), (const bf16_t*)(p->ws + WS_WPOOL) + (size_t)i * 1024 * 256, 1024, 256, 256, 256, T / 256, 4, 0, nullptr, nullptr, 0, 0, 1};
            Epi<EM_RES> E{(bf16_t*)(p->ws + WS_H), nullptr, nullptr, nullptr, MOD + (size_t)layer * 5 * MODW + 2 * D, p->in[I_PSCALE] + i * D, nullptr};
#ifndef DIS_POOL
            pg8::gemm_phase(tid_o, bid_o, lds, g, E); return;
#else
            return;
#endif
        }
    }
}


#define XB_TMO      128
#define XB_XCNT(j)  (256  + 64 * (j))
#define XB_XSUB(j)  (1280 + 64 * (j))
#define XB_XGEN(j)  (2304 + 64 * (j))
#define XB_TOP      3328
#define XB_TOPGEN   3392
#define XCD_BAR_WORDS 3456
#define XB_SPIN_CAP (1u << 22)
DI unsigned xb_ld(unsigned* p)              { return __hip_atomic_load(p, __ATOMIC_RELAXED, __HIP_MEMORY_SCOPE_AGENT); }
DI unsigned xb_add(unsigned* p, unsigned v) { return __hip_atomic_fetch_add(p, v, __ATOMIC_RELAXED, __HIP_MEMORY_SCOPE_AGENT); }
DI unsigned xb_xcc_id() { return (unsigned)__builtin_amdgcn_s_getreg((3 << 11) | 20) & 0xFu; }
#define XB_SPIN(cond, bar) do { unsigned _sp = 0; while (cond) { __builtin_amdgcn_s_sleep(1); \
    if ((++_sp & 255u) == 0u) { if (xb_ld(&(bar)[XB_TMO])) break; if (_sp > XB_SPIN_CAP) { atomicAdd(&(bar)[XB_TMO], 1u); break; } } } } while (0)
DI void xcd_barrier_complete(unsigned* bar, unsigned x, unsigned& nloc, unsigned& nx) {
    const unsigned G = gridDim.x;
    unsigned sum, cnt, mine, sp = 0u;
    for (;;) {
        sum = 0u; cnt = 0u; mine = 0u;
#pragma unroll
        for (unsigned j = 0; j < 16; ++j) { const unsigned c = xb_ld(&bar[XB_XCNT(j)]); sum += c; cnt += (c > 0u) ? 1u : 0u; mine = (j == x) ? c : mine; }
        if (sum == G) break;
        __builtin_amdgcn_s_sleep(1);
        if ((++sp & 255u) == 0u) { if (xb_ld(&bar[XB_TMO])) break; if (sp > XB_SPIN_CAP) { atomicAdd(&bar[XB_TMO], 1u); break; } }
    }
    nloc = mine > 0u ? mine : 1u; nx = cnt > 0u ? cnt : 1u;
}
DI void xcd_barrier(unsigned* bar, unsigned x, volatile LAS unsigned* st, int tid) {
    asm volatile("s_waitcnt vmcnt(0)" ::: "memory");
    __syncthreads();
    if (tid == 0) {
        __builtin_amdgcn_s_waitcnt(0);
        unsigned nloc = st[0], nx = st[1];
        if (nloc == 0u) { xcd_barrier_complete(bar, x, nloc, nx); st[0] = nloc; st[1] = nx; }
        const unsigned old = xb_add(&bar[XB_XSUB(x)], 1u);
        const unsigned gen = old / nloc;
        if (old + 1u == (gen + 1u) * nloc) {
            __builtin_amdgcn_fence(__ATOMIC_RELEASE, "agent");
            asm volatile("s_waitcnt vmcnt(0)" ::: "memory");
            const unsigned og = xb_add(&bar[XB_TOP], 1u);
            const unsigned tg = og / nx;
            if (og + 1u == (tg + 1u) * nx) xb_add(&bar[XB_TOPGEN], 1u);
            else XB_SPIN(xb_ld(&bar[XB_TOPGEN]) == tg, bar);
            __builtin_amdgcn_fence(__ATOMIC_ACQUIRE, "agent");
            xb_add(&bar[XB_XGEN(x)], 1u);
            asm volatile("s_waitcnt vmcnt(0)" ::: "memory");
        } else {
            XB_SPIN(xb_ld(&bar[XB_XGEN(x)]) == gen, bar);
            __builtin_amdgcn_fence(__ATOMIC_ACQUIRE, "agent");
            asm volatile("s_waitcnt vmcnt(0)" ::: "memory");
        }
    }
    __syncthreads();
}

#ifndef REPMASK
#define REPMASK 0
#endif
DI int phase_class(int ph) {
    if (ph == 0) return 0;
    if (ph == 31) return 15;
    const int q = ph - 1, r = q % 15; const bool ab = r < 9; const int s = ab ? r : r - 9, n2 = ab ? 6 : 3;
    if (s == 0 || s == n2) return 1;
    if (s == n2 + 1) return 7;
    if (s == n2 + 2) return 15;
    if (ab) { if (s == 1) return 2; if (s == 2) return 3; if (s == 3) return 4; if (s == 4) return 5; if (s == 5) return ph == 6 ? 6 : 15; }
    else { if (s == 1) return 8; }
    return 15;
}
__global__ void __launch_bounds__(512, 2) fwd_megakernel(Params p) {
    extern __shared__ __attribute__((aligned(16))) unsigned char smem[];
    LAS unsigned char* lds = (LAS unsigned char*)smem;
    volatile LAS unsigned* xst = (volatile LAS unsigned*)(lds + XST_OFF);
    unsigned* bar = (unsigned*)(p.ws + WS_CTL);
    const unsigned xcc = xb_xcc_id();
    if (p.coop) {
        if (threadIdx.x == 0) { xst[0] = 0u; xst[1] = 0u; (void)xb_add(&bar[XB_XCNT(xcc)], 1u); }
        __syncthreads();
    }
    if (p.ph_lo < 0) cg::this_grid().sync();
    for (int ph = p.ph_lo; ph < p.ph_hi; ++ph) {
#if REPMASK
        const int reps = 1 + ((REPMASK >> phase_class(ph)) & 1);
#else
        const int reps = 1;
#endif
#pragma nounroll
        for (int rep = 0; rep < reps; ++rep) {
            int tid_o = (int)__builtin_amdgcn_workitem_id_x(), bid_o = (int)__builtin_amdgcn_workgroup_id_x();
            asm volatile("" : "+v"(tid_o)); asm volatile("" : "+s"(bid_o));
            KP kp = (KP)__builtin_amdgcn_kernarg_segment_ptr(); asm volatile("" : "+s"(kp));
            run_phase(tid_o, bid_o, kp, lds, ph);
            if (rep + 1 < reps || ph + 1 < p.ph_hi) xcd_barrier(bar, xcc, xst, tid_o);
        }
    }
}

extern "C" void kernel_launch(void* const* d_in, const int* in_sizes, int n_in, void* d_out, int out_size, void* d_ws, size_t ws_size, hipStream_t stream) {
    static int grid = 0;
    if (grid == 0) {
        if (n_in != 24 || ws_size < WS_TOTAL) { fprintf(stderr, "kernel_launch: unexpected n_in %d / ws_size %zu (need %zu)\n", n_in, ws_size, (size_t)WS_NEED); grid = -1; return; }
        int dev = 0, cus = 0, per_cu = 0;
        hipGetDevice(&dev);
        hipDeviceGetAttribute(&cus, hipDeviceAttributeMultiprocessorCount, dev);
        if (hipFuncSetAttribute((const void*)fwd_megakernel, hipFuncAttributeMaxDynamicSharedMemorySize, LDS_BYTES) != hipSuccess) { fprintf(stderr, "kernel_launch: hipFuncSetAttribute failed\n"); grid = -1; return; }
        if (hipOccupancyMaxActiveBlocksPerMultiprocessor(&per_cu, (const void*)fwd_megakernel, 512, LDS_BYTES) != hipSuccess || per_cu < 1) { fprintf(stderr, "kernel_launch: occupancy query gave %d\n", per_cu); per_cu = 1; (void)hipGetLastError(); }
        grid = cus * 1;
        if (grid <= 0) grid = 256;
    }
    if (grid < 0) return;
    Params p{};
    for (int i = 0; i < 24; ++i) p.in[i] = (const float*)d_in[i];
    p.out = (float*)d_out; p.ws = (unsigned char*)d_ws;
#if MK_COOP
    p.ph_lo = 0; p.ph_hi = NPHASE; p.coop = 1;
    (void)hipMemsetAsync((char*)d_ws + WS_CTL, 0, CTL_BYTES, stream);
    void* args[] = {&p};
    hipError_t e = hipLaunchCooperativeKernel((const void*)fwd_megakernel, dim3(grid), dim3(512), args, LDS_BYTES, stream);
    if (e != hipSuccess) fprintf(stderr, "cooperative launch failed: %s (grid %d)\n", hipGetErrorString(e), grid);
#else
    for (int ph = 0; ph < NPHASE; ++ph) {
        p.ph_lo = ph; p.ph_hi = ph + 1;
        hipLaunchKernelGGL(fwd_megakernel, dim3(grid), dim3(512), LDS_BYTES, stream, p);
    }
#endif
}
```

```cpp
#include <hip/hip_runtime.h>
#include <hip/hip_cooperative_groups.h>
#include <cstdio>
#include <cstdint>
namespace cg = cooperative_groups;

#ifndef MK_COOP
#define MK_COOP 1
#endif

#define DI __device__ __forceinline__
#define LAS __attribute__((address_space(3)))
typedef unsigned short bf16_t;
typedef short bf16x8 __attribute__((ext_vector_type(8)));
typedef float f32x2 __attribute__((ext_vector_type(2)));
typedef float f32x4 __attribute__((ext_vector_type(4)));
typedef float f32x16 __attribute__((ext_vector_type(16)));
typedef unsigned u32x2 __attribute__((ext_vector_type(2)));
typedef unsigned u32x4 __attribute__((ext_vector_type(4)));
typedef __bf16 bf16x2_t __attribute__((ext_vector_type(2)));

constexpr int D = 1024, T_CTX = 8192, T_LAT = 16384, T = T_CTX + T_LAT;
constexpr int LLAT = 4608, KR = T_CTX + 4 * LLAT;
constexpr int NZ = 1792, FF = 4096;
constexpr int MODW = 6144;
constexpr float EPS = 1e-6f;
constexpr float QSCALE = 0.10206207261596577f * 1.4426950408889634f;
constexpr size_t OUT_CKV = (size_t)T * D, OUT_KPE = OUT_CKV + (size_t)32 * 2 * 256 * 256;
constexpr size_t KF_CTX = (size_t)32 * 8 * 256 * 96, VT_CTX = (size_t)32 * 8 * 64 * 256;

constexpr size_t WS_WIN = 0;
constexpr size_t WS_WQB = WS_WIN + (size_t)2 * NZ * 1024 * 2;
constexpr size_t WS_WK = WS_WQB + (size_t)2 * 768 * 384 * 2;
constexpr size_t WS_WV = WS_WK + (size_t)2 * 512 * 256 * 2;
constexpr size_t WS_WOUT = WS_WV + (size_t)2 * 512 * 256 * 2;
constexpr size_t WS_WPOOL = WS_WOUT + (size_t)2 * 1024 * 1024 * 2;
constexpr size_t WS_WSP = WS_WPOOL + (size_t)2 * 1024 * 256 * 2;
constexpr size_t WS_WFF1 = WS_WSP + (size_t)2 * 8 * 128 * 128 * 2;
constexpr size_t WS_WFF2 = WS_WFF1 + (size_t)4 * FF * 1024 * 2;
constexpr size_t WS_MOD = WS_WFF2 + (size_t)4 * FF * 1024 * 2;
constexpr size_t WS_H = WS_MOD + (size_t)4 * 5 * MODW * 4;
constexpr size_t WS_U = WS_H + (size_t)T * 1024 * 2;
constexpr size_t WS_Z = WS_U;
constexpr size_t WS_QN = WS_Z + (size_t)T * NZ * 2;
constexpr size_t WS_CKV = WS_QN + (size_t)T * 384 * 2;
constexpr size_t WS_Q = WS_CKV + (size_t)KR * 256 * 2;
constexpr size_t WS_KF = WS_Q + (size_t)T * 768 * 2;
constexpr size_t WS_VT = WS_KF + (size_t)KR * 8 * 96 * 2;
constexpr size_t WS_VN = WS_VT + (size_t)KR * 512 * 2;
constexpr size_t WS_END1 = WS_VN + (size_t)T * 512 * 2;
constexpr size_t WS_FFH = WS_U;
constexpr size_t WS_PD = WS_U;
constexpr size_t WS_END2 = WS_FFH + (size_t)T * FF * 2;
constexpr size_t WS_DELTA = WS_END2;
static_assert(WS_DELTA + (size_t)T * 1024 * 2 <= WS_END1, "delta");
constexpr size_t WS_NEED = WS_END1 > WS_END2 ? WS_END1 : WS_END2;
static_assert(WS_NEED <= (size_t)402653184, "workspace map exceeds 4x largest tensor");

constexpr int XST_OFF = 131072;
constexpr int LDS_BYTES = 131072 + 64;
constexpr size_t WS_CTL = (WS_NEED + 255) & ~(size_t)255, CTL_BYTES = 32768;
constexpr size_t WS_KPE = WS_CTL + CTL_BYTES;
constexpr size_t WS_TOTAL = WS_KPE + (size_t)KR * 32 * 2;
static_assert(WS_TOTAL <= (size_t)402653184, "ctl");
constexpr int NPHASE = 32;

struct Params {
    const float* in[24];
    float* out;
    unsigned char* ws;
    int ph_lo, ph_hi;
    int coop, pad;
};
typedef const __attribute__((address_space(4))) Params* KP;
enum { I_XP = 0, I_XS, I_CCKV, I_CKPE, I_C, I_CCTX, I_WMOD, I_BMOD, I_N1G, I_N2G, I_WIN, I_QAG, I_KVAG, I_WQB, I_WKVB, I_VG, I_WSP, I_BSP, I_WOUT, I_WPOOL, I_PSCALE, I_WFF1, I_WFF2, I_FG };

DI unsigned pk_bf16(float lo, float hi) { f32x2 v = {lo, hi}; bf16x2_t b = __builtin_convertvector(v, bf16x2_t); return __builtin_bit_cast(unsigned, b); }
DI float bf_lo(unsigned u) { return __builtin_bit_cast(float, u << 16); }
DI float bf_hi(unsigned u) { return __builtin_bit_cast(float, u & 0xffff0000u); }
DI float bf1(bf16_t u) { return __builtin_bit_cast(float, (unsigned)u << 16); }
DI bf16_t f2bf(float f) { return (bf16_t)(pk_bf16(f, 0.f) & 0xffffu); }
DI float wave_sum(float v) {
#pragma unroll
    for (int o = 32; o; o >>= 1) v += __shfl_xor(v, o);
    return v;
}
DI int cond_of_row(int row) { return row < T_CTX ? 4 : ((row - T_CTX) >> 12); }
DI void sincos_rr(float x, float& s, float& c) {
    const float n = rintf(x * 0.15915494309189535f);
    float r = fmaf(-n, 6.2831854820251465f, x);
    r = fmaf(-n, -1.7484556000744883e-07f, r);
    s = __sinf(r); c = __cosf(r);
}
DI float rope_inv(int f) { return exp2f(-(float)f * 1.6609640474436813f); }
DI float gelu_tanh(float x) {
    const float u = 0.7978845608028654f * (x + 0.044715f * x * x * x);
    const float t = __builtin_amdgcn_exp2f(-2.885390081777927f * u);
    return x * __builtin_amdgcn_rcpf(1.f + t);
}

namespace pg8 {
constexpr int BM = 256, BK = 64, HALF = 128, HTB = HALF * BK * 2, NXCD = 8, WGM = 8;
DI int lds_byte(int r, int c) { const int st = (r >> 4) * 2 + (c >> 5), rr = r & 15, cc = c & 31, ob = rr * 64 + cc * 2; return st * 1024 + (ob ^ (((ob >> 9) & 1) << 5)); }
DI void stage_rc(int b, int& R, int& C) { const int st = b / 1024, sb = b % 1024, swz = sb ^ (((sb >> 9) & 1) << 5); R = (st >> 1) * 16 + swz / 64; C = (st & 1) * 32 + (swz % 64) / 2; }
DI int perm32(int rho) { const int n = rho >> 4, i = rho & 15; return 8 * (i >> 2) + 4 * n + (i & 3); }
struct Unit { int pm, pn, kt0, nt, role, slot, mh; };
struct Gemm { const bf16_t* A; const bf16_t* Bt; int lda, ldb, K, a_pn_step, nM, nN, rot; float* P; unsigned* flags; int tiledA, tiledB, msplit; };

DI bool next_unit(int bid_o, const Gemm& g, int i, Unit& u) {
    const int G = gridDim.x; int c = bid_o + g.rot; if (c >= G) c -= G;
    const int nwg = g.nM * g.nN, ntf = g.K / BK;
    const int R = nwg / G, r = nwg - R * G;
    const bool split = g.P != nullptr && r > 0 && 2 * r <= G;
    long L; u.kt0 = 0; u.nt = ntf; u.role = 0; u.slot = 0; u.mh = 0;
    const bool msp = g.msplit && r > 0 && 2 * r <= G;
    if (msp) {
        if (i < R) L = (long)i * G + c;
        else if (i == R && c < 2 * r) { L = (long)R * G + (c >> 1); u.mh = 1 + (c & 1); }
        else return false;
    } else
    if (split && c < 2 * r) {
        const bool prod = (c & 1) == 0;
        if (i > R) return false;
        if (prod ? (i == 0) : (i == R)) { L = (long)R * G + (c >> 1); u.nt = ntf / 2; u.kt0 = prod ? 0 : ntf / 2; u.role = prod ? 1 : 2; u.slot = c >> 1; }
        else L = (long)(prod ? i - 1 : i) * G + c;
    } else {
        L = (long)i * G + c;
        if (split ? (i >= R) : (L >= nwg)) return false;
    }
    int wgid = (int)L; { const int q = nwg / NXCD, rr = nwg % NXCD, xcd = wgid % NXCD, off = wgid / NXCD; wgid = (xcd < rr ? xcd * (q + 1) : rr * (q + 1) + (xcd - rr) * q) + off; }
    const int nig = WGM * g.nN, gid = wgid / nig, fm = gid * WGM, gsz = (g.nM - fm) < WGM ? (g.nM - fm) : WGM;
    u.pm = fm + ((wgid % nig) % gsz); u.pn = (wgid % nig) / gsz; return true;
}

template <class EpiT>
DI void gemm_phase(int tid_o, int bid_o, LAS unsigned char* lds, const Gemm g, const EpiT& E) {
    const int tid = tid_o, wid = __builtin_amdgcn_readfirstlane(tid >> 6), lane = tid & 63, wr = wid >> 2, wc = wid & 3, fr = lane & 15, fq = lane >> 4;
    const int ldaE = g.tiledA ? 64 : g.lda, ldbE = g.tiledB ? 64 : g.ldb;
    unsigned voffA[2], voffB[2];
#pragma unroll
    for (int i = 0; i < 2; ++i) { int R, C; stage_rc(tid * 16 + i * 8192, R, C); const int Rb = (R & ~31) + perm32(R & 31);
        voffA[i] = (unsigned)(R * ldaE + C) * 2u; voffB[i] = (unsigned)(Rb * ldbE + C) * 2u; }
    const size_t kstepA = g.tiledA ? 32768 : 128, kstepB = g.tiledB ? 32768 : 128;
    const size_t hstepA = (size_t)HALF * ldaE * 2, hstepB = (size_t)HALF * ldbE * 2;
    const size_t tstepA = g.tiledA ? (size_t)512 * g.K : 2 * hstepA, tstepB = g.tiledB ? (size_t)512 * g.K : 2 * hstepB;
    const unsigned ldsw = (unsigned)wid * 1024u;
    const int aoff = lds_byte(wr * 64 + fr, fq * 8), boff = lds_byte(wc * 32 + fr, fq * 8);
#define PG8_SA(b, h) (((b) * 2 + (h)) * HTB)
#define PG8_SB(b, h) ((4 + (b) * 2 + (h)) * HTB)
#define PG8_STAGE(bufoff, gbase, voff) do { _Pragma("unroll") for (int _i = 0; _i < 2; ++_i) \
        __builtin_amdgcn_global_load_lds((const unsigned*)((const char*)(gbase) + (voff)[_i]), (LAS unsigned*)(lds + (bufoff) + ldsw + _i * 8192), 16, 0, 0); } while (0)
#define PG8_LDA(dst, b, h) do { _Pragma("unroll") for (int m = 0; m < 4; ++m) _Pragma("unroll") for (int k = 0; k < 2; ++k) dst[m][k] = *(const LAS bf16x8*)(lds + PG8_SA(b, h) + aoff + m * 2048 + k * 1024); } while (0)
#define PG8_LDB(dst, b, h) do { _Pragma("unroll") for (int n = 0; n < 2; ++n) _Pragma("unroll") for (int k = 0; k < 2; ++k) dst[n][k] = *(const LAS bf16x8*)(lds + PG8_SB(b, h) + boff + n * 2048 + k * 1024); } while (0)
#define PG8_MMA(ai, bj, At, Bt) do { __builtin_amdgcn_s_setprio(1); _Pragma("unroll") for (int m = 0; m < 4; ++m) _Pragma("unroll") for (int n = 0; n < 2; ++n) _Pragma("unroll") for (int k = 0; k < 2; ++k) \
        acc[ai][bj][m][n] = __builtin_amdgcn_mfma_f32_16x16x32_bf16(Bt[n][k], At[m][k], acc[ai][bj][m][n], 0, 0, 0); __builtin_amdgcn_s_setprio(0); } while (0)
#define PG8_WAIT_V(n) asm volatile("s_waitcnt vmcnt(" #n ")" ::: "memory")
#define PG8_WAIT_L(n) asm volatile("s_waitcnt lgkmcnt(" #n ")" ::: "memory")
#define PG8_BAR __builtin_amdgcn_s_barrier()
#define PG8_SCHED __builtin_amdgcn_sched_barrier(0)
    Unit cur, nxt; int ui = 0;
    if (!next_unit(bid_o, g, 0, cur)) return;
    f32x4 acc[2][2][4][2];
#pragma unroll
    for (int a = 0; a < 2; ++a)
#pragma unroll
        for (int b = 0; b < 2; ++b)
#pragma unroll
            for (int m = 0; m < 4; ++m)
#pragma unroll
                for (int n = 0; n < 2; ++n) acc[a][b][m][n] = (f32x4){0.f, 0.f, 0.f, 0.f};
    bf16x8 At[4][2], B0[2][2], B1[2][2];
    const char* cA = (const char*)g.A + (size_t)cur.pm * tstepA + (size_t)cur.pn * g.a_pn_step * 2 + (size_t)cur.kt0 * kstepA + (cur.mh == 2 ? hstepA : 0); const char* cB = (const char*)g.Bt + (size_t)cur.pn * tstepB + (size_t)cur.kt0 * kstepB;
    PG8_STAGE(PG8_SB(0, 0), cB, voffB); PG8_STAGE(PG8_SB(0, 1), cB + hstepB, voffB); PG8_STAGE(PG8_SA(0, 0), cA, voffA); PG8_STAGE(PG8_SA(0, 1), cA + (cur.mh ? 0 : hstepA), voffA);
    if (wr == 1) PG8_BAR;
    PG8_WAIT_V(2); PG8_BAR;
    PG8_STAGE(PG8_SB(1, 0), cB + kstepB, voffB); PG8_STAGE(PG8_SA(1, 0), cA + kstepA, voffA); PG8_STAGE(PG8_SB(1, 1), cB + hstepB + kstepB, voffB);
    PG8_WAIT_V(6); PG8_BAR;
    for (;;) {
        const bool has_next = next_unit(bid_o, g, ui + 1, nxt);
        const char* nA = has_next ? (const char*)g.A + (size_t)nxt.pm * tstepA + (size_t)nxt.pn * g.a_pn_step * 2 + (size_t)nxt.kt0 * kstepA + (nxt.mh == 2 ? hstepA : 0) : cA;
        const size_t hAc = cur.mh ? 0 : hstepA, hAn = has_next ? (nxt.mh ? 0 : hstepA) : hAc;
        const bool fullM = cur.mh == 0; const char* nB = has_next ? (const char*)g.Bt + (size_t)nxt.pn * tstepB + (size_t)nxt.kt0 * kstepB : cB;
        const int nt = cur.nt;
#pragma nounroll
        for (int t = 0; t < nt; t += 2) {
            const bool last = (t == nt - 2);
            const char* a1 = cA + (size_t)(t + 1) * kstepA;
            const char* a2 = last ? nA : cA + (size_t)(t + 2) * kstepA; const char* b2 = last ? nB : cB + (size_t)(t + 2) * kstepB;
            const char* a3 = a2 + kstepA; const char* b3 = b2 + kstepB;
            PG8_LDB(B0, 0, 0); PG8_LDB(B1, 0, 1); PG8_SCHED; PG8_LDA(At, 0, 0); PG8_STAGE(PG8_SA(1, 1), a1 + hAc, voffA);
            PG8_WAIT_V(8); PG8_WAIT_L(0); PG8_BAR; PG8_MMA(0, 0, At, B0); PG8_MMA(0, 1, At, B1); PG8_BAR; PG8_SCHED;
            PG8_LDA(At, 0, 1); PG8_STAGE(PG8_SB(0, 0), b2, voffB); PG8_STAGE(PG8_SB(0, 1), b2 + hstepB, voffB); PG8_STAGE(PG8_SA(0, 0), a2, voffA);
            PG8_WAIT_V(8); PG8_WAIT_L(0); PG8_BAR; if (fullM) { PG8_MMA(1, 0, At, B0); PG8_MMA(1, 1, At, B1); } PG8_BAR; PG8_SCHED;
            PG8_LDB(B0, 1, 0); PG8_LDB(B1, 1, 1); PG8_SCHED; PG8_LDA(At, 1, 0); PG8_STAGE(PG8_SA(0, 1), a2 + (last ? hAn : hAc), voffA);
            PG8_WAIT_V(8); PG8_WAIT_L(0); PG8_BAR; PG8_MMA(0, 0, At, B0); PG8_MMA(0, 1, At, B1); PG8_BAR; PG8_SCHED;
            PG8_LDA(At, 1, 1); PG8_STAGE(PG8_SB(1, 0), b3, voffB); PG8_STAGE(PG8_SB(1, 1), b3 + hstepB, voffB); PG8_STAGE(PG8_SA(1, 0), a3, voffA);
            PG8_WAIT_V(8); PG8_WAIT_L(0); PG8_BAR; if (fullM) { PG8_MMA(1, 0, At, B0); PG8_MMA(1, 1, At, B1); } PG8_BAR; PG8_SCHED;
        }
        if (wr == 0) PG8_BAR;
        if (cur.role == 1) {
            float* pp = g.P + (size_t)cur.slot * 65536 + tid * 4;
#pragma unroll
            for (int a = 0; a < 2; ++a)
#pragma unroll
                for (int b = 0; b < 2; ++b)
#pragma unroll
                    for (int m = 0; m < 4; ++m)
#pragma unroll
                        for (int n = 0; n < 2; ++n) *(f32x4*)(pp + (size_t)(((a * 2 + b) * 4 + m) * 2 + n) * 2048) = acc[a][b][m][n];
            asm volatile("s_waitcnt vmcnt(0)" ::: "memory");
            __syncthreads();
            if (tid == 0) { __builtin_amdgcn_fence(__ATOMIC_RELEASE, "agent"); asm volatile("s_waitcnt vmcnt(0)" ::: "memory"); __hip_atomic_fetch_add(g.flags + cur.slot, 1u, __ATOMIC_RELAXED, __HIP_MEMORY_SCOPE_AGENT); }
        } else {
            if (cur.role == 2) {
                if (tid == 0) {
                    unsigned sp = 0;
                    while (__hip_atomic_load(g.flags + cur.slot, __ATOMIC_RELAXED, __HIP_MEMORY_SCOPE_AGENT) == 0u) { __builtin_amdgcn_s_sleep(1); if (++sp > (1u << 24)) break; }
                    __builtin_amdgcn_fence(__ATOMIC_ACQUIRE, "agent"); asm volatile("s_waitcnt vmcnt(0)" ::: "memory");
                }
                __syncthreads();
            }
            E(acc, cur, wr, wc, fr, fq, cur.role == 2 ? g.P + (size_t)cur.slot * 65536 + tid * 4 : (const float*)nullptr);
        }
        if (!has_next) break;
#pragma unroll
        for (int a = 0; a < 2; ++a)
#pragma unroll
            for (int b = 0; b < 2; ++b)
#pragma unroll
                for (int m = 0; m < 4; ++m)
#pragma unroll
                    for (int n = 0; n < 2; ++n) acc[a][b][m][n] = (f32x4){0.f, 0.f, 0.f, 0.f};
        cur = nxt; cA = nA; cB = nB; ++ui;
        if (wr == 1) PG8_BAR;
    }
    PG8_WAIT_V(0);
    PG8_BAR;
#undef PG8_SA
#undef PG8_SB
#undef PG8_STAGE
#undef PG8_LDA
#undef PG8_LDB
#undef PG8_MMA
#undef PG8_WAIT_V
#undef PG8_WAIT_L
#undef PG8_BAR
#undef PG8_SCHED
}
}

enum { EM_Z = 0, EM_Q, EM_K, EM_VT, EM_RES, EM_FF1 };
template <int mode> struct Epi {
    bf16_t* O;
    float* X;
    const float* xin0; const float* xin1;
    const float* gate;
    const float* cscale;
    const bf16_t* kpe;
    DI void operator()(const f32x4 (&acc)[2][2][4][2], const pg8::Unit& u, int wr, int wc, int fr, int fq, const float* part) const {
        const int row0 = u.pm * 256 + wr * 64 + fr;
        const int col0 = u.pn * 256 + wc * 32 + 8 * fq;
        if (mode == EM_Z || mode == EM_FF1) {
            const int ld = mode == EM_Z ? NZ : FF;
            const bool gel = (mode == EM_Z) && (u.pn >= 3);
            const bool sq = (mode == EM_FF1);
#pragma unroll
            for (int ai = 0; ai < 2; ++ai)
#pragma unroll
                for (int m = 0; m < 4; ++m) {
                    bf16_t* rowp = sq ? O + (size_t)u.pm * 256 * FF + (size_t)(u.pn * 4 + (wc >> 1)) * 16384 + (size_t)(wr * 64 + fr + ai * 128 + m * 16) * 64 + (wc & 1) * 32 + 8 * fq
                                     : O + (size_t)(row0 + ai * 128 + m * 16) * ld + col0;
#pragma unroll
                    for (int bj = 0; bj < 2; ++bj) {
                        f32x4 v0 = acc[ai][bj][m][0], v1 = acc[ai][bj][m][1];
                        if (gel) {
#pragma unroll
                            for (int e = 0; e < 4; ++e) { v0[e] = gelu_tanh(v0[e]); v1[e] = gelu_tanh(v1[e]); }
                        }
                        if (sq) {
#pragma unroll
                            for (int e = 0; e < 4; ++e) { float a = fmaxf(v0[e], 0.f), b = fmaxf(v1[e], 0.f); v0[e] = a * a; v1[e] = b * b; }
                        }
                        u32x4 w; w.x = pk_bf16(v0[0], v0[1]); w.y = pk_bf16(v0[2], v0[3]); w.z = pk_bf16(v1[0], v1[1]); w.w = pk_bf16(v1[2], v1[3]);
                        *(u32x4*)(rowp + (sq ? bj * 2 * 16384 : bj * 128)) = w;
                    }
                }
        } else if (mode == EM_Q) {
#pragma unroll
            for (int bj = 0; bj < 2; ++bj) {
                const int c = col0 + bj * 128;
                const int j0 = c % 96;
                const bool rope_cols = j0 >= 64;
                const int jj0 = j0 - 64, ax = jj0 >> 4, fbase = (jj0 & 15) >> 1;
                float inv[4];
#pragma unroll
                for (int e = 0; e < 4; ++e) inv[e] = rope_inv(fbase + e);
#pragma unroll
                for (int ai = 0; ai < 2; ++ai)
#pragma unroll
                    for (int m = 0; m < 4; ++m) {
                        const int row = row0 + ai * 128 + m * 16;
                        f32x4 v0 = acc[ai][bj][m][0] * QSCALE, v1 = acc[ai][bj][m][1] * QSCALE;
                        if (rope_cols && row >= T_CTX) {
                            const int tt = (row - T_CTX) & 4095;
                            const float pos = (float)(ax == 0 ? (tt >> 6) : (tt & 63));
                            float s, cs, a, b;
                            sincos_rr(pos * inv[0], s, cs); a = v0[0]; b = v0[1]; v0[0] = a * cs - b * s; v0[1] = b * cs + a * s;
                            sincos_rr(pos * inv[1], s, cs); a = v0[2]; b = v0[3]; v0[2] = a * cs - b * s; v0[3] = b * cs + a * s;
                            sincos_rr(pos * inv[2], s, cs); a = v1[0]; b = v1[1]; v1[0] = a * cs - b * s; v1[1] = b * cs + a * s;
                            sincos_rr(pos * inv[3], s, cs); a = v1[2]; b = v1[3]; v1[2] = a * cs - b * s; v1[3] = b * cs + a * s;
                        }
                        u32x4 w; w.x = pk_bf16(v0[0], v0[1]); w.y = pk_bf16(v0[2], v0[3]); w.z = pk_bf16(v1[0], v1[1]); w.w = pk_bf16(v1[2], v1[3]);
                        *(u32x4*)(O + (size_t)row * 768 + c) = w;
                    }
            }
        } else if (mode == EM_K) {
            const int kr0 = u.pm * 256;
            size_t base; int L, l0;
            if (kr0 < T_CTX) { const int b = kr0 >> 8; L = 256; l0 = 0; base = (size_t)b * 8 * 256 * 96; }
            else { const int kk = kr0 - T_CTX, b = kk / LLAT; L = LLAT; l0 = kk - b * LLAT; base = KF_CTX + (size_t)b * 8 * LLAT * 96; }
#pragma unroll
            for (int bj = 0; bj < 2; ++bj) {
                const int c = col0 + bj * 128, h = c >> 6, j = c & 63;
#pragma unroll
                for (int ai = 0; ai < 2; ++ai)
#pragma unroll
                    for (int m = 0; m < 4; ++m) {
                        const int l = l0 + wr * 64 + fr + ai * 128 + m * 16;
                        const f32x4 v0 = acc[ai][bj][m][0], v1 = acc[ai][bj][m][1];
                        u32x4 w; w.x = pk_bf16(v0[0], v0[1]); w.y = pk_bf16(v0[2], v0[3]); w.z = pk_bf16(v1[0], v1[1]); w.w = pk_bf16(v1[2], v1[3]);
                        *(u32x4*)(O + base + ((size_t)h * L + l) * 96 + j) = w;
                    }
            }
            {
                const int tid = (wr * 4 + wc) * 64 + fq * 16 + fr;
#pragma unroll
                for (int q2 = 0; q2 < 2; ++q2) {
                    const int pr = tid + 512 * q2, r = pr & 255, h = u.pn * 4 + (pr >> 8);
                    const u32x4* src = (const u32x4*)(kpe + (size_t)(kr0 + r) * 32);
                    u32x4* dst = (u32x4*)(O + base + ((size_t)h * L + l0 + r) * 96 + 64);
                    const u32x4 c0 = src[0], c1 = src[1], c2 = src[2], c3 = src[3];
                    dst[0] = c0; dst[1] = c1; dst[2] = c2; dst[3] = c3;
                }
            }
        } else if (mode == EM_VT) {
            const int kr0 = u.pn * 256;
            size_t base; int L, l0;
            if (kr0 < T_CTX) { const int b = kr0 >> 8; L = 256; l0 = 0; base = (size_t)b * 8 * 64 * 256; }
            else { const int kk = kr0 - T_CTX, b = kk / LLAT; L = LLAT; l0 = kk - b * LLAT; base = VT_CTX + (size_t)b * 8 * 64 * LLAT; }
#pragma unroll
            for (int ai = 0; ai < 2; ++ai)
#pragma unroll
                for (int m = 0; m < 4; ++m) {
                    const int f = row0 + ai * 128 + m * 16;
#pragma unroll
                    for (int bj = 0; bj < 2; ++bj) {
                        const int l = l0 + wc * 32 + 8 * fq + bj * 128;
                        const f32x4 v0 = acc[ai][bj][m][0], v1 = acc[ai][bj][m][1];
                        u32x4 w; w.x = pk_bf16(v0[0], v0[1]); w.y = pk_bf16(v0[2], v0[3]); w.z = pk_bf16(v1[0], v1[1]); w.w = pk_bf16(v1[2], v1[3]);
                        *(u32x4*)(O + base + (size_t)f * L + l) = w;
                    }
                }
        } else {
            typedef _Float16 h16x8_t __attribute__((ext_vector_type(8)));
            typedef float f32x8_t __attribute__((ext_vector_type(8)));
            _Float16* X = (_Float16*)O;
            const int b = cond_of_row(u.pm * 256);
            const float* gp = gate + (size_t)b * MODW;
#pragma unroll
            for (int bj = 0; bj < 2; ++bj) {
                const int c = col0 + bj * 128;
                f32x4 g0 = *(const f32x4*)(gp + c), g1 = *(const f32x4*)(gp + c + 4);
                if (cscale) { g0 = g0 * *(const f32x4*)(cscale + c); g1 = g1 * *(const f32x4*)(cscale + c + 4); }
                h16x8_t xv[2][4];
#pragma unroll
                for (int ai = 0; ai < 2; ++ai)
#pragma unroll
                    for (int m = 0; m < 4; ++m) {
                        if (ai == 1 && u.mh) continue;
                        const int row = row0 + (u.mh == 2 ? 128 : 0) + ai * 128 + m * 16;
                        xv[ai][m] = *(const h16x8_t*)(X + (size_t)row * D + c);
                    }
#pragma unroll
                for (int ai = 0; ai < 2; ++ai)
#pragma unroll
                    for (int m = 0; m < 4; ++m) {
                        if (ai == 1 && u.mh) continue;
                        const int row = row0 + (u.mh == 2 ? 128 : 0) + ai * 128 + m * 16;
                        const f32x4 a0 = acc[ai][bj][m][0] * g0, a1 = acc[ai][bj][m][1] * g1;
                        f32x8_t xf = __builtin_convertvector(xv[ai][m], f32x8_t);
                        xf[0] += a0[0]; xf[1] += a0[1]; xf[2] += a0[2]; xf[3] += a0[3]; xf[4] += a1[0]; xf[5] += a1[1]; xf[6] += a1[2]; xf[7] += a1[3];
                        *(h16x8_t*)(X + (size_t)row * D + c) = __builtin_convertvector(xf, h16x8_t);
                    }
            }
        }
    }
};

struct TDesc { const float* src; bf16_t* dst; int ld, K, N, perm, tiled; };
DI int tperm(int perm, int n) {
    if (perm == 0) return n;
    if (perm == 1) return n < 672 ? n : (n < 768 ? -1 : n - 96);
    if (perm == 2) { const int h = n / 96, j = n - h * 96; if (j < 64) return n; const int jj = j - 64, a = jj >> 4, r = jj & 15, f = r >> 1, pp = r & 1; return h * 96 + 64 + a * 16 + pp * 8 + f; }
    if (perm == 3) return (n >> 6) * 128 + (n & 63);
    return (n >> 6) * 128 + 64 + (n & 63);
}
DI bool tdesc_find(KP p, int tile, TDesc& d, int& local) {
    int t = tile;
#define TD_TRY(SRC, DST, LD, KK, NN, PERM) { const int cnt = ((KK) / 64) * ((NN) / 32); if (t < cnt) { d.src = (SRC); d.dst = (DST); d.ld = (LD); d.K = (KK); d.N = (NN); d.perm = (PERM) & 15; d.tiled = (PERM) >> 4; local = t; return true; } t -= cnt; }
    for (int i = 0; i < 4; ++i) TD_TRY(p->in[I_WFF1] + (size_t)i * 1024 * FF, (bf16_t*)(p->ws + WS_WFF1) + (size_t)i * FF * 1024, FF, 1024, FF, 0)
    for (int i = 0; i < 4; ++i) TD_TRY(p->in[I_WFF2] + (size_t)i * FF * 1024, (bf16_t*)(p->ws + WS_WFF2) + (size_t)i * 1024 * FF, 1024, FF, 1024, 16)
    for (int i = 0; i < 2; ++i) TD_TRY(p->in[I_WIN] + (size_t)i * 1024 * 1696, (bf16_t*)(p->ws + WS_WIN) + (size_t)i * NZ * 1024, 1696, 1024, NZ, 1)
    for (int i = 0; i < 2; ++i) TD_TRY(p->in[I_WOUT] + (size_t)i * 1024 * 1024, (bf16_t*)(p->ws + WS_WOUT) + (size_t)i * 1024 * 1024, 1024, 1024, 1024, 0)
    for (int i = 0; i < 2; ++i) TD_TRY(p->in[I_WQB] + (size_t)i * 384 * 768, (bf16_t*)(p->ws + WS_WQB) + (size_t)i * 768 * 384, 768, 384, 768, 2)
    for (int i = 0; i < 2; ++i) TD_TRY(p->in[I_WKVB] + (size_t)i * 256 * 1024, (bf16_t*)(p->ws + WS_WK) + (size_t)i * 512 * 256, 1024, 256, 512, 3)
    for (int i = 0; i < 2; ++i) TD_TRY(p->in[I_WKVB] + (size_t)i * 256 * 1024, (bf16_t*)(p->ws + WS_WV) + (size_t)i * 512 * 256, 1024, 256, 512, 4)
    for (int i = 0; i < 8; ++i) TD_TRY(p->in[I_WPOOL] + (size_t)i * 256 * 256, (bf16_t*)(p->ws + WS_WPOOL) + (size_t)i * 256 * 256, 256, 256, 256, 0)
#undef TD_TRY
    return false;
}
constexpr int N_TITEMS = 2 * 896 + 2 * 144 + 2 * 64 + 2 * 64 + 2 * 512 + 8 * 32 + 4 * 2048 + 4 * 2048;
constexpr int N_MODU = 4 * 48;

DI void prologue_phase(int tid_o, int bid_o, KP p, LAS unsigned char* lds) {
    const int tid = tid_o, wid = tid >> 6, lane = tid & 63;
    LAS float* lf = (LAS float*)lds;
    for (int u = bid_o; u < N_MODU; u += gridDim.x) {
        const int l = u / 48, cb = u % 48;
        LAS float* sl = lf;
        LAS float* red = lf + 5120;
        for (int idx = tid; idx < 5120; idx += 512) { const int r = idx >> 10, k = idx & 1023; const float c = r < 4 ? p->in[I_C][r * 1024 + k] : p->in[I_CCTX][k]; sl[idx] = c / (1.f + __expf(-c)); }
        __syncthreads();
        float a[5][2];
#pragma unroll
        for (int r = 0; r < 5; ++r) { a[r][0] = 0.f; a[r][1] = 0.f; }
        const float* wp = p->in[I_WMOD] + ((size_t)l * 1024 + wid * 128) * MODW + cb * 128 + lane * 2;
#pragma unroll 16
        for (int kk = 0; kk < 128; ++kk) {
            const f32x2 wv = __builtin_nontemporal_load((const f32x2*)(wp + (size_t)kk * MODW));
#pragma unroll
            for (int r = 0; r < 5; ++r) { const float s = sl[r * 1024 + wid * 128 + kk]; a[r][0] += s * wv.x; a[r][1] += s * wv.y; }
        }
#pragma unroll
        for (int r = 0; r < 5; ++r) { red[(wid * 5 + r) * 128 + lane * 2] = a[r][0]; red[(wid * 5 + r) * 128 + lane * 2 + 1] = a[r][1]; }
        __syncthreads();
        for (int idx = tid; idx < 640; idx += 512) {
            const int r = idx >> 7, c = idx & 127; float s = p->in[I_BMOD][l * MODW + cb * 128 + c];
#pragma unroll
            for (int w = 0; w < 8; ++w) s += red[(w * 5 + r) * 128 + c];
            ((float*)(p->ws + WS_MOD))[(size_t)(l * 5 + r) * MODW + cb * 128 + c] = s;
        }
        __syncthreads();
    }
    for (int idx = bid_o * 512 + tid; idx < 32768; idx += gridDim.x * 512) {
        const int e0 = idx * 8;
        const f32x4 a = *(const f32x4*)(p->in[I_WSP] + e0), b = *(const f32x4*)(p->in[I_WSP] + e0 + 4);
        u32x4 w; w.x = pk_bf16(a[0], a[1]); w.y = pk_bf16(a[2], a[3]); w.z = pk_bf16(b[0], b[1]); w.w = pk_bf16(b[2], b[3]);
        *(u32x4*)((bf16_t*)(p->ws + WS_WSP) + e0) = w;
    }
    LAS float* sc = (LAS float*)(lds + 40960 + wid * 8448);
    const int G = gridDim.x;
    const bool lowb = bid_o < N_MODU && G > N_MODU;
    const int pool0 = G > N_MODU ? (N_TITEMS / 32) * 21 : N_TITEMS;
    const int it_begin = lowb ? bid_o * 8 + wid : (G > N_MODU ? pool0 + (bid_o - N_MODU) * 8 + wid : bid_o * 8 + wid);
    const int it_end = lowb ? pool0 : N_TITEMS;
    const int it_step = lowb ? N_MODU * 8 : (G > N_MODU ? (G - N_MODU) * 8 : G * 8);
    for (int it = it_begin; it < it_end; it += it_step) {
        TDesc d; int local;
        if (!tdesc_find(p, it, d, local)) continue;
        const int tiles_n = d.N / 32, tn = local % tiles_n, tk = local / tiles_n, n0 = tn * 32, k0 = tk * 64;
        { const int c = lane & 31, kh = lane >> 5; const int scol = tperm(d.perm, n0 + c);
            const float* sp = d.src + (size_t)(k0 + kh * 32) * d.ld + (scol >= 0 ? scol : 0);
            float v[32];
#pragma unroll
            for (int j = 0; j < 32; ++j) v[j] = scol >= 0 ? __builtin_nontemporal_load(sp + (size_t)j * d.ld) : 0.f;
#pragma unroll
            for (int j = 0; j < 32; ++j) sc[(kh * 32 + j) * 33 + c] = v[j]; }
        { const int ch = lane & 7, n = lane >> 3;
#pragma unroll
            for (int j4 = 0; j4 < 4; ++j4) { const int nn = n + 8 * j4; const LAS float* q = sc + (8 * ch) * 33 + nn;
                u32x4 o; o.x = pk_bf16(q[0 * 33], q[1 * 33]); o.y = pk_bf16(q[2 * 33], q[3 * 33]); o.z = pk_bf16(q[4 * 33], q[5 * 33]); o.w = pk_bf16(q[6 * 33], q[7 * 33]);
                bf16_t* dp = d.tiled ? d.dst + ((size_t)((n0 + nn) >> 8) * (d.K / 64) + tk) * 16384 + (size_t)((n0 + nn) & 255) * 64 + 8 * ch : d.dst + (size_t)(n0 + nn) * d.K + k0 + 8 * ch;
                *(u32x4*)dp = o; } }
    }
}

typedef _Float16 h16x4 __attribute__((ext_vector_type(4)));
DI void norm_phase(int tid_o, int bid_o, KP p, int layer, int which, bool first, bool final_) {
    const int wid = tid_o >> 6, lane = tid_o & 63;
    const float* gw = final_ ? p->in[I_FG] : (which == 0 ? p->in[I_N1G] : p->in[I_N2G]) + layer * D;
    bf16_t* H = (bf16_t*)(p->ws + WS_DELTA);
    _Float16* X16 = (_Float16*)(p->ws + WS_H);
    constexpr int NR = 4;
    const int rstep = gridDim.x * 8 * NR;
    h16x4 nx[NR][4];
    if (!first) {
        const int r0 = (bid_o * 8 + wid) * NR;
        if (r0 < T) {
#pragma unroll
            for (int r = 0; r < NR; ++r)
#pragma unroll
                for (int j = 0; j < 4; ++j) nx[r][j] = *(const h16x4*)(X16 + (size_t)(r0 + r) * D + j * 256 + lane * 4);
        }
    }
    for (int row0 = (bid_o * 8 + wid) * NR; row0 < T; row0 += rstep) {
        f32x4 v[NR][4];
        if (first) {
#pragma unroll
            for (int r = 0; r < NR; ++r) {
                const int row = row0 + r;
                const float* xr = row < T_CTX ? p->in[I_XP] + (size_t)row * D : p->in[I_XS] + (size_t)(row - T_CTX) * D;
#pragma unroll
                for (int j = 0; j < 4; ++j) v[r][j] = *(const f32x4*)(xr + j * 256 + lane * 4);
            }
        } else {
#pragma unroll
            for (int r = 0; r < NR; ++r)
#pragma unroll
                for (int j = 0; j < 4; ++j) v[r][j] = __builtin_convertvector(nx[r][j], f32x4);
            if (row0 + rstep < T) {
#pragma unroll
                for (int r = 0; r < NR; ++r)
#pragma unroll
                    for (int j = 0; j < 4; ++j) nx[r][j] = *(const h16x4*)(X16 + (size_t)(row0 + rstep + r) * D + j * 256 + lane * 4);
            }
        }
        float ss[NR];
#pragma unroll
        for (int r = 0; r < NR; ++r) {
            ss[r] = 0.f;
#pragma unroll
            for (int j = 0; j < 4; ++j) ss[r] += v[r][j][0] * v[r][j][0] + v[r][j][1] * v[r][j][1] + v[r][j][2] * v[r][j][2] + v[r][j][3] * v[r][j][3];
        }
#pragma unroll
        for (int o = 32; o; o >>= 1)
#pragma unroll
            for (int r = 0; r < NR; ++r) ss[r] += __shfl_xor(ss[r], o);
        float rs[NR];
#pragma unroll
        for (int r = 0; r < NR; ++r) rs[r] = rsqrtf(ss[r] * (1.f / D) + EPS);
        if (final_) {
#pragma unroll
            for (int j = 0; j < 4; ++j) {
                const int c = j * 256 + lane * 4; const f32x4 g4 = *(const f32x4*)(gw + c);
#pragma unroll
                for (int r = 0; r < NR; ++r) *(f32x4*)(p->out + (size_t)(row0 + r) * D + c) = v[r][j] * rs[r] * g4;
            }
        } else {
            if (first) {
#pragma unroll
                for (int r = 0; r < NR; ++r)
#pragma unroll
                    for (int j = 0; j < 4; ++j) *(h16x4*)(X16 + (size_t)(row0 + r) * D + j * 256 + lane * 4) = __builtin_convertvector(v[r][j], h16x4);
            }
            const float* md = (const float*)(p->ws + WS_MOD) + (size_t)(layer * 5 + cond_of_row(row0)) * MODW + (which ? 3 * D : 0);
#pragma unroll
            for (int j = 0; j < 4; ++j) {
                const int c = j * 256 + lane * 4;
                const f32x4 g4 = *(const f32x4*)(gw + c), sh = *(const f32x4*)(md + c), sc = *(const f32x4*)(md + D + c);
                const f32x4 gm = g4 * (sc + 1.f);
#pragma unroll
                for (int r = 0; r < NR; ++r) {
                    const f32x4 y = v[r][j] * rs[r] * gm + sh;
                    u32x2 w; w.x = pk_bf16(y[0], y[1]); w.y = pk_bf16(y[2], y[3]);
                    *(u32x2*)(H + (size_t)(row0 + r) * D + c) = w;
                }
            }
        }
    }
}

DI void rowop_phase(int tid_o, int bid_o, KP p, int i) {
    const int wid = tid_o >> 6, lane = tid_o & 63;
    const bf16_t* Z = (const bf16_t*)(p->ws + WS_Z);
    bf16_t* QN = (bf16_t*)(p->ws + WS_QN); bf16_t* CKV = (bf16_t*)(p->ws + WS_CKV); bf16_t* KPE = (bf16_t*)(p->ws + WS_KPE); bf16_t* VN = (bf16_t*)(p->ws + WS_VN);
    const float* qag = p->in[I_QAG] + i * 384; const float* kvg = p->in[I_KVAG] + i * 256; const float* vg = p->in[I_VG] + i * 512;
    constexpr int NR = 4;
    for (int it0 = (bid_o * 8 + wid) * NR; it0 < T; it0 += gridDim.x * 8 * NR) {
        u32x2 zz[NR][5];
#pragma unroll
        for (int r = 0; r < NR; ++r) {
            const bf16_t* zr = Z + (size_t)(it0 + r) * NZ;
            zz[r][0] = *(const u32x2*)(zr + 4 * lane); zz[r][1] = *(const u32x2*)(zr + 4 * (64 + lane)); zz[r][2] = *(const u32x2*)(zr + 4 * (128 + (lane < 40 ? lane : 0)));
            zz[r][3] = *(const u32x2*)(zr + 4 * (320 + lane)); zz[r][4] = *(const u32x2*)(zr + 4 * (384 + lane));
        }
#pragma unroll
        for (int r = 0; r < NR; ++r) {
            const int row = it0 + r;
            const u32x2 z0 = zz[r][0], z1 = zz[r][1], z2 = zz[r][2], z5 = zz[r][3], z6 = zz[r][4];
            float a0[4] = {bf_lo(z0.x), bf_hi(z0.x), bf_lo(z0.y), bf_hi(z0.y)};
            float a1[4] = {bf_lo(z1.x), bf_hi(z1.x), bf_lo(z1.y), bf_hi(z1.y)};
            float a2[4] = {bf_lo(z2.x), bf_hi(z2.x), bf_lo(z2.y), bf_hi(z2.y)};
            float a5[4] = {bf_lo(z5.x), bf_hi(z5.x), bf_lo(z5.y), bf_hi(z5.y)};
            float a6[4] = {bf_lo(z6.x), bf_hi(z6.x), bf_lo(z6.y), bf_hi(z6.y)};
            const float s0 = a0[0] * a0[0] + a0[1] * a0[1] + a0[2] * a0[2] + a0[3] * a0[3];
            const float s1 = a1[0] * a1[0] + a1[1] * a1[1] + a1[2] * a1[2] + a1[3] * a1[3];
            const float s2 = a2[0] * a2[0] + a2[1] * a2[1] + a2[2] * a2[2] + a2[3] * a2[3];
            const float s5 = a5[0] * a5[0] + a5[1] * a5[1] + a5[2] * a5[2] + a5[3] * a5[3] + a6[0] * a6[0] + a6[1] * a6[1] + a6[2] * a6[2] + a6[3] * a6[3];
            const float ssq = wave_sum(s0 + (lane < 32 ? s1 : 0.f));
            const float sskv = wave_sum((lane >= 32 ? s1 : 0.f) + (lane < 32 ? s2 : 0.f));
            const float ssv = wave_sum(s5);
            const float rq = rsqrtf(ssq * (1.f / 384.f) + EPS), rkv = rsqrtf(sskv * (1.f / 256.f) + EPS), rv = rsqrtf(ssv * (1.f / 512.f) + EPS);
            int krow, l, L; size_t kfbase; bool lat = row >= T_CTX; int b, tt;
            if (!lat) { b = row >> 8; tt = row & 255; krow = row; l = tt; L = 256; kfbase = (size_t)b * 8 * 256 * 96; }
            else { const int r2 = row - T_CTX; b = r2 >> 12; tt = r2 & 4095; krow = T_CTX + b * LLAT + 512 + tt; l = 512 + tt; L = LLAT; kfbase = KF_CTX + (size_t)b * 8 * LLAT * 96; }
            { const int c = 4 * lane; const f32x4 g = *(const f32x4*)(qag + c); u32x2 w; w.x = pk_bf16(a0[0] * rq * g[0], a0[1] * rq * g[1]); w.y = pk_bf16(a0[2] * rq * g[2], a0[3] * rq * g[3]); *(u32x2*)(QN + (size_t)row * 384 + c) = w; }
            if (lane < 32) { const int c = 256 + 4 * lane; const f32x4 g = *(const f32x4*)(qag + c); u32x2 w; w.x = pk_bf16(a1[0] * rq * g[0], a1[1] * rq * g[1]); w.y = pk_bf16(a1[2] * rq * g[2], a1[3] * rq * g[3]); *(u32x2*)(QN + (size_t)row * 384 + c) = w; }
            {
                const bool hi = lane >= 32; const int c = hi ? 4 * (lane - 32) : 128 + 4 * lane;
                const f32x4 g = *(const f32x4*)(kvg + c);
                f32x4 y;
#pragma unroll
                for (int e = 0; e < 4; ++e) y[e] = (hi ? a1[e] : a2[e]) * rkv * g[e];
                u32x2 w; w.x = pk_bf16(y[0], y[1]); w.y = pk_bf16(y[2], y[3]);
                *(u32x2*)(CKV + (size_t)krow * 256 + c) = w;
                if (!lat) *(f32x4*)(p->out + OUT_CKV + ((size_t)(b * 2 + i) * 256 + tt) * 256 + c) = y;
            }
            {
                const int j0 = ((lane - 32) & 7) * 4;
                float o[4], pr[4], op[4];
#pragma unroll
                for (int e = 0; e < 4; ++e) pr[e] = __shfl_xor(a2[e], 2);
                const int ax = j0 >> 4, pbit = (j0 >> 3) & 1, f0 = j0 & 7;
                if (lat) {
                    const float pos = (float)(ax == 0 ? (tt >> 6) : (tt & 63));
#pragma unroll
                    for (int e = 0; e < 4; ++e) { float s, cs; sincos_rr(pos * rope_inv(f0 + e), s, cs); o[e] = pbit ? (a2[e] * cs + pr[e] * s) : (a2[e] * cs - pr[e] * s); }
                } else {
#pragma unroll
                    for (int e = 0; e < 4; ++e) o[e] = a2[e];
                }
#pragma unroll
                for (int e = 0; e < 4; ++e) op[e] = __shfl_xor(o[e], 2);
                if (lane >= 32 && lane < 40) {
                    if (!lat) *(f32x4*)(p->out + OUT_KPE + ((size_t)(b * 2 + i) * 256 + tt) * 32 + j0) = (f32x4){a2[0], a2[1], a2[2], a2[3]};
                    u32x2 w;
                    if (pbit == 0) { w.x = pk_bf16(o[0], op[0]); w.y = pk_bf16(o[1], op[1]); }
                    else { w.x = pk_bf16(op[2], o[2]); w.y = pk_bf16(op[3], o[3]); }
                    *(u32x2*)(KPE + (size_t)krow * 32 + ax * 16 + 2 * (f0 + 2 * pbit)) = w;
                }
            }
            { const int c = 4 * lane; const f32x4 g = *(const f32x4*)(vg + c); u32x2 w; w.x = pk_bf16(a5[0] * rv * g[0], a5[1] * rv * g[1]); w.y = pk_bf16(a5[2] * rv * g[2], a5[3] * rv * g[3]); *(u32x2*)(VN + (size_t)row * 512 + c) = w; }
            { const int c = 256 + 4 * lane; const f32x4 g = *(const f32x4*)(vg + c); u32x2 w; w.x = pk_bf16(a6[0] * rv * g[0], a6[1] * rv * g[1]); w.y = pk_bf16(a6[2] * rv * g[2], a6[3] * rv * g[3]); *(u32x2*)(VN + (size_t)row * 512 + c) = w; }
        }
    }
    for (int it = bid_o * 8 + wid; it < 2048; it += gridDim.x * 8) {
        {
            const int r = it, b = r >> 9, pp = r & 511;
            const float* src = p->in[I_CCKV] + ((size_t)(b * 2 + i) * 512 + pp) * 256;
            const f32x4 v = *(const f32x4*)(src + 4 * lane);
            u32x2 w; w.x = pk_bf16(v[0], v[1]); w.y = pk_bf16(v[2], v[3]);
            *(u32x2*)(CKV + (size_t)(T_CTX + b * LLAT + pp) * 256 + 4 * lane) = w;
            {
                const f32x4 k = *(const f32x4*)(p->in[I_CKPE] + ((size_t)(b * 2 + i) * 512 + pp) * 32 + 4 * (lane & 7));
                const int j0 = 4 * (lane & 7), ax = j0 >> 4, pbit = (j0 >> 3) & 1, f0 = j0 & 7;
                float op[4];
#pragma unroll
                for (int e = 0; e < 4; ++e) op[e] = __shfl_xor(k[e], 2);
                if (lane < 8) {
                    u32x2 w;
                    if (pbit == 0) { w.x = pk_bf16(k[0], op[0]); w.y = pk_bf16(k[1], op[1]); }
                    else { w.x = pk_bf16(op[2], k[2]); w.y = pk_bf16(op[3], k[3]); }
                    *(u32x2*)(KPE + (size_t)(T_CTX + b * LLAT + pp) * 32 + ax * 16 + 2 * (f0 + 2 * pbit)) = w;
                }
            }
        }
    }
}

constexpr int AK_ROW = 208, AV_ROW = 136, AK_BUF = 64 * AK_ROW, AV_BUF = 64 * AV_ROW, AV_OFF = 2 * AK_BUF;
#define MFMA32(a, b, c) __builtin_amdgcn_mfma_f32_32x32x16_bf16((a), (b), (c), 0, 0, 0)
DI void attn_unit(int tid_o, LAS unsigned char* lds, const bf16_t* Qb, const bf16_t* Kb, const bf16_t* Vb, int L, bf16_t* Ob) {
    const int tid = tid_o, wid = tid >> 6, lane = tid & 63, r32 = lane & 31, hh = lane >> 5;
    bf16x8 qf[6];
    { const bf16_t* qp = Qb + (size_t)(wid * 32 + r32) * 768 + hh * 8;
#pragma unroll
        for (int s = 0; s < 6; ++s) qf[s] = *(const bf16x8*)(qp + s * 16); }
    const bool lo256 = tid < 256;
    const int c1 = tid + 512;
    const bf16_t* g0 = Kb; const unsigned go0 = (tid / 12) * 96 + (tid % 12) * 8;
    const unsigned l0 = (tid / 12) * AK_ROW + (tid % 12) * 16;
    const bf16_t* g1 = lo256 ? Kb : Vb; const unsigned go1 = lo256 ? (c1 / 12) * 96 + (c1 % 12) * 8 : (unsigned)((tid - 256) >> 3) * L + ((tid - 256) & 7) * 8;
    const unsigned l1 = lo256 ? (c1 / 12) * AK_ROW + (c1 % 12) * 16 : AV_OFF + ((tid - 256) >> 3) * AV_ROW + ((tid - 256) & 7) * 16;
    const bf16_t* g2 = Vb; const unsigned go2 = (unsigned)((tid + 256) >> 3) * L + ((tid + 256) & 7) * 8;
    const unsigned l2 = AV_OFF + ((tid + 256) >> 3) * AV_ROW + ((tid + 256) & 7) * 16;
    const int st1 = lo256 ? 64 * 96 : 64;
    const int nt = L / 64;
    u32x4 s0r, s1r, s2r;
    s0r = *(const u32x4*)(g0 + go0); s1r = *(const u32x4*)(g1 + go1); if (lo256) s2r = *(const u32x4*)(g2 + go2);
    {
        *(LAS u32x4*)(lds + l0) = s0r;
        if (lo256) { *(LAS u32x4*)(lds + l1) = s1r; *(LAS u32x2*)(lds + l2) = (u32x2){s2r.x, s2r.y}; *(LAS u32x2*)(lds + l2 + 8) = (u32x2){s2r.z, s2r.w}; }
        else { *(LAS u32x2*)(lds + l1) = (u32x2){s1r.x, s1r.y}; *(LAS u32x2*)(lds + l1 + 8) = (u32x2){s1r.z, s1r.w}; }
    }
    __syncthreads();
    f32x16 o0, o1;
#pragma unroll
    for (int e = 0; e < 16; ++e) { o0[e] = 0.f; o1[e] = 0.f; }
    float mrun = -INFINITY, lsum = 0.f;
    for (int kt = 0; kt < nt; ++kt) {
        const int buf = kt & 1;
        const bool pre = kt + 1 < nt;
        if (pre) {
            s0r = *(const u32x4*)(g0 + (go0 + (unsigned)(kt + 1) * 64 * 96)); s1r = *(const u32x4*)(g1 + (go1 + (unsigned)(kt + 1) * st1)); if (lo256) s2r = *(const u32x4*)(g2 + (go2 + (unsigned)(kt + 1) * 64));
        }
        f32x16 sa, sb;
#pragma unroll
        for (int e = 0; e < 16; ++e) { sa[e] = 0.f; sb[e] = 0.f; }
        const LAS unsigned char* kb = lds + buf * AK_BUF + r32 * AK_ROW + hh * 16;
        __builtin_amdgcn_s_setprio(1);
#pragma unroll
        for (int s = 0; s < 6; ++s) {
            const bf16x8 a0 = *(const LAS bf16x8*)(kb + s * 32), a1 = *(const LAS bf16x8*)(kb + 32 * AK_ROW + s * 32);
            sa = MFMA32(a0, qf[s], sa); sb = MFMA32(a1, qf[s], sb);
        }
        __builtin_amdgcn_s_setprio(0);
        __builtin_amdgcn_sched_barrier(0);
        float mx = sa[0];
#pragma unroll
        for (int e = 1; e < 16; ++e) mx = fmaxf(mx, sa[e]);
#pragma unroll
        for (int e = 0; e < 16; ++e) mx = fmaxf(mx, sb[e]);
        mx = fmaxf(mx, __shfl_xor(mx, 32));
        const float mn = fmaxf(mrun, mx);
        const float alpha = __builtin_amdgcn_exp2f(mrun - mn);
        mrun = mn;
        float ps = 0.f;
#pragma unroll
        for (int e = 0; e < 16; ++e) { sa[e] = __builtin_amdgcn_exp2f(sa[e] - mn); ps += sa[e]; }
#pragma unroll
        for (int e = 0; e < 16; ++e) { sb[e] = __builtin_amdgcn_exp2f(sb[e] - mn); ps += sb[e]; }
        lsum = lsum * alpha + ps;
        o0 = o0 * alpha; o1 = o1 * alpha;
        __builtin_amdgcn_sched_barrier(0);
        const LAS unsigned char* vb = lds + AV_OFF + buf * AV_BUF + r32 * AV_ROW + hh * 8;
#pragma unroll
        for (int kb2 = 0; kb2 < 2; ++kb2)
#pragma unroll
            for (int s = 0; s < 2; ++s) {
                u32x4 pw;
                if (kb2 == 0) { pw.x = pk_bf16(sa[8 * s + 0], sa[8 * s + 1]); pw.y = pk_bf16(sa[8 * s + 2], sa[8 * s + 3]); pw.z = pk_bf16(sa[8 * s + 4], sa[8 * s + 5]); pw.w = pk_bf16(sa[8 * s + 6], sa[8 * s + 7]); }
                else { pw.x = pk_bf16(sb[8 * s + 0], sb[8 * s + 1]); pw.y = pk_bf16(sb[8 * s + 2], sb[8 * s + 3]); pw.z = pk_bf16(sb[8 * s + 4], sb[8 * s + 5]); pw.w = pk_bf16(sb[8 * s + 6], sb[8 * s + 7]); }
                const bf16x8 pb = __builtin_bit_cast(bf16x8, pw);
                const int ko = (kb2 * 32 + 16 * s) * 2;
                const u32x2 v0l = *(const LAS u32x2*)(vb + ko), v0h = *(const LAS u32x2*)(vb + ko + 16);
                const u32x2 v1l = *(const LAS u32x2*)(vb + 32 * AV_ROW + ko), v1h = *(const LAS u32x2*)(vb + 32 * AV_ROW + ko + 16);
                const bf16x8 va0 = __builtin_bit_cast(bf16x8, (u32x4){v0l.x, v0l.y, v0h.x, v0h.y});
                const bf16x8 va1 = __builtin_bit_cast(bf16x8, (u32x4){v1l.x, v1l.y, v1h.x, v1h.y});
                o0 = MFMA32(va0, pb, o0); o1 = MFMA32(va1, pb, o1);
            }
        if (pre) {
            const unsigned bo = (buf ^ 1) * AK_BUF, vo = (buf ^ 1) * AV_BUF;
            *(LAS u32x4*)(lds + bo + l0) = s0r;
            if (lo256) { *(LAS u32x4*)(lds + bo + l1) = s1r; *(LAS u32x2*)(lds + vo + l2) = (u32x2){s2r.x, s2r.y}; *(LAS u32x2*)(lds + vo + l2 + 8) = (u32x2){s2r.z, s2r.w}; }
            else { *(LAS u32x2*)(lds + vo + l1) = (u32x2){s1r.x, s1r.y}; *(LAS u32x2*)(lds + vo + l1 + 8) = (u32x2){s1r.z, s1r.w}; }
        }
        __syncthreads();
    }
    const float lt = lsum + __shfl_xor(lsum, 32);
    const float inv = 1.f / lt;
    bf16_t* op = Ob + (size_t)(wid * 32 + r32) * D + 4 * hh;
#pragma unroll
    for (int g = 0; g < 4; ++g) {
        u32x2 w0; w0.x = pk_bf16(o0[4 * g] * inv, o0[4 * g + 1] * inv); w0.y = pk_bf16(o0[4 * g + 2] * inv, o0[4 * g + 3] * inv);
        u32x2 w1; w1.x = pk_bf16(o1[4 * g] * inv, o1[4 * g + 1] * inv); w1.y = pk_bf16(o1[4 * g + 2] * inv, o1[4 * g + 3] * inv);
        *(u32x2*)(op + 8 * g) = w0; *(u32x2*)(op + 32 + 8 * g) = w1;
    }
}
DI void attn_phase(int tid_o, int bid_o, KP p, LAS unsigned char* lds) {
    const bf16_t* Q = (const bf16_t*)(p->ws + WS_Q); const bf16_t* KF = (const bf16_t*)(p->ws + WS_KF); const bf16_t* VT = (const bf16_t*)(p->ws + WS_VT);
    bf16_t* MIX = (bf16_t*)((unsigned char*)p->out);
    for (int u = bid_o; u < 768; u += gridDim.x) {
        if (u < 512) {
            const int x = u & 7, r = u >> 3, bh = x * 4 + (r >> 4), qb = r & 15, b = bh >> 3, h = bh & 7;
            const int tok0 = T_CTX + b * 4096 + qb * 256;
            attn_unit(tid_o, lds, Q + (size_t)tok0 * 768 + h * 96, KF + KF_CTX + (size_t)(b * 8 + h) * LLAT * 96, VT + VT_CTX + (size_t)(b * 8 + h) * 64 * LLAT, LLAT, MIX + (size_t)tok0 * D + h * 64);
        } else {
            const int bh = u - 512, b = bh >> 3, h = bh & 7;
            const int tok0 = b * 256;
            attn_unit(tid_o, lds, Q + (size_t)tok0 * 768 + h * 96, KF + (size_t)(b * 8 + h) * 256 * 96, VT + (size_t)(b * 8 + h) * 64 * 256, 256, MIX + (size_t)tok0 * D + h * 64);
        }
    }
}

DI void spatial_phase(int tid_o, int bid_o, KP p, LAS unsigned char* lds, int i) {
    const int tid = tid_o, wid = tid >> 6, lane = tid & 63, fr = lane & 15, fq = lane >> 4;
    const bf16_t* VN = (const bf16_t*)(p->ws + WS_VN); const bf16_t* Z = (const bf16_t*)(p->ws + WS_Z); const bf16_t* WSP = (const bf16_t*)(p->ws + WS_WSP) + (size_t)i * 8 * 128 * 128;
    bf16_t* MIX = (bf16_t*)((unsigned char*)p->out);
    const float* bs = p->in[I_BSP] + i * 8 * 128;
    const int NU = (T / 128) * 8;
    u32x4 vv[2];
    if (bid_o < NU) {
        const int chunk = bid_o >> 3, g = bid_o & 7, tok0 = chunk * 128;
#pragma unroll
        for (int k = 0; k < 2; ++k) { const int id = tid + 512 * k, q = id >> 3, c0 = (id & 7) * 8; vv[k] = *(const u32x4*)(VN + (size_t)(tok0 + q) * 512 + g * 64 + c0); }
    }
    for (int u = bid_o; u < NU; u += gridDim.x) {
        const int chunk = u >> 3, g = u & 7, tok0 = chunk * 128;
#pragma unroll
        for (int k = 0; k < 2; ++k) {
            const int id = tid + 512 * k, q = id >> 3, c0 = (id & 7) * 8;
            const u32x4 v = vv[k];
            LAS bf16_t* dst = (LAS bf16_t*)(lds + c0 * 272 + q * 2);
            dst[0 * 136] = (bf16_t)(v.x & 0xffff); dst[1 * 136] = (bf16_t)(v.x >> 16); dst[2 * 136] = (bf16_t)(v.y & 0xffff); dst[3 * 136] = (bf16_t)(v.y >> 16);
            dst[4 * 136] = (bf16_t)(v.z & 0xffff); dst[5 * 136] = (bf16_t)(v.z >> 16); dst[6 * 136] = (bf16_t)(v.w & 0xffff); dst[7 * 136] = (bf16_t)(v.w >> 16);
        }
        __syncthreads();
        { const int un = u + gridDim.x;
          if (un < NU) { const int chn = un >> 3, gn = un & 7, tk0 = chn * 128;
#pragma unroll
            for (int k = 0; k < 2; ++k) { const int id = tid + 512 * k, q = id >> 3, c0 = (id & 7) * 8; vv[k] = *(const u32x4*)(VN + (size_t)(tk0 + q) * 512 + gn * 64 + c0); } } }
        const int prow = 16 * wid + fr, tok = tok0 + prow;
        u32x2 uu[4];
#pragma unroll
        for (int n = 0; n < 4; ++n) uu[n] = *(const u32x2*)(Z + (size_t)tok * NZ + 768 + g * 64 + 16 * n + 4 * fq);
        const float bias = bs[g * 128 + prow];
        bf16x8 wa[4];
#pragma unroll
        for (int k = 0; k < 4; ++k) wa[k] = *(const bf16x8*)(WSP + ((size_t)g * 128 + 16 * wid + fr) * 128 + 32 * k + fq * 8);
        f32x4 acc[4];
#pragma unroll
        for (int n = 0; n < 4; ++n) acc[n] = (f32x4){0.f, 0.f, 0.f, 0.f};
#pragma unroll
        for (int k = 0; k < 4; ++k) {
#pragma unroll
            for (int n = 0; n < 4; ++n) {
                const bf16x8 b = *(const LAS bf16x8*)(lds + (16 * n + fr) * 272 + (32 * k + fq * 8) * 2);
                acc[n] = __builtin_amdgcn_mfma_f32_16x16x32_bf16(b, wa[k], acc[n], 0, 0, 0);
            }
        }
#pragma unroll
        for (int n = 0; n < 4; ++n) {
            const int ch = g * 64 + 16 * n + 4 * fq;
            u32x2 w; w.x = pk_bf16(bf_lo(uu[n].x) * (acc[n][0] + bias), bf_hi(uu[n].x) * (acc[n][1] + bias)); w.y = pk_bf16(bf_lo(uu[n].y) * (acc[n][2] + bias), bf_hi(uu[n].y) * (acc[n][3] + bias));
            *(u32x2*)(MIX + (size_t)tok * D + 512 + ch) = w;
        }
        __syncthreads();
    }
}

template <int HW>
DI void pd_item(const bf16_t* hb, bf16_t* pb, int tt0, int len) {
    constexpr int NRW = 8 + 2 * HW;
    u32x4 rw[NRW];
#pragma unroll
    for (int k = 0; k < NRW; ++k) {
        const int t2 = tt0 - HW + k;
        rw[k] = (t2 >= 0 && t2 < len) ? *(const u32x4*)(hb + (size_t)t2 * D) : (u32x4){0u, 0u, 0u, 0u};
    }
    float sum[8];
#pragma unroll
    for (int e = 0; e < 8; ++e) sum[e] = 0.f;
#pragma unroll
    for (int k = 0; k < 2 * HW; ++k) {
        sum[0] += bf_lo(rw[k].x); sum[1] += bf_hi(rw[k].x); sum[2] += bf_lo(rw[k].y); sum[3] += bf_hi(rw[k].y); sum[4] += bf_lo(rw[k].z); sum[5] += bf_hi(rw[k].z); sum[6] += bf_lo(rw[k].w); sum[7] += bf_hi(rw[k].w);
    }
#pragma unroll
    for (int j = 0; j < 8; ++j) {
        const int tt = tt0 + j, lo = max(tt - HW, 0), hi = min(tt + HW, len);
        const float ic = 1.f / (float)(hi - lo);
        const u32x4 v = rw[j + HW];
        u32x4 w;
        w.x = pk_bf16(sum[0] * ic - bf_lo(v.x), sum[1] * ic - bf_hi(v.x)); w.y = pk_bf16(sum[2] * ic - bf_lo(v.y), sum[3] * ic - bf_hi(v.y));
        w.z = pk_bf16(sum[4] * ic - bf_lo(v.z), sum[5] * ic - bf_hi(v.z)); w.w = pk_bf16(sum[6] * ic - bf_lo(v.w), sum[7] * ic - bf_hi(v.w));
        *(u32x4*)(pb + (size_t)tt * D) = w;
        if (j < 7) {
            const u32x4 a = rw[j + 2 * HW], s2 = rw[j];
            sum[0] += bf_lo(a.x) - bf_lo(s2.x); sum[1] += bf_hi(a.x) - bf_hi(s2.x); sum[2] += bf_lo(a.y) - bf_lo(s2.y); sum[3] += bf_hi(a.y) - bf_hi(s2.y);
            sum[4] += bf_lo(a.z) - bf_lo(s2.z); sum[5] += bf_hi(a.z) - bf_hi(s2.z); sum[6] += bf_lo(a.w) - bf_lo(s2.w); sum[7] += bf_hi(a.w) - bf_hi(s2.w);
        }
    }
}
DI void pooldiff_phase(int tid_o, int bid_o, KP p) {
    const bf16_t* H = (const bf16_t*)(p->ws + WS_DELTA); bf16_t* PD = (bf16_t*)(p->ws + WS_PD);
    const int wid = tid_o >> 6, lane = tid_o & 63;
    for (int wi = bid_o * 8 + wid; wi < (T / 16) * 4; wi += gridDim.x * 8) {
        const int gi = wi & 3, tb = (wi >> 2) * 2 + (lane >> 5), c0 = gi * 256 + (lane & 31) * 8;
        const int tok0 = tb * 8;
        int s0, len;
        if (tok0 < T_CTX) { s0 = tok0 & ~255; len = 256; } else { s0 = T_CTX + ((tok0 - T_CTX) & ~4095); len = 4096; }
        const int tt0 = tok0 - s0;
        const bf16_t* hb = H + (size_t)s0 * D + c0; bf16_t* pb = PD + (size_t)s0 * D + c0;
        if (gi == 0) pd_item<1>(hb, pb, tt0, len);
        else if (gi == 1) pd_item<2>(hb, pb, tt0, len);
        else if (gi == 2) pd_item<4>(hb, pb, tt0, len);
        else pd_item<8>(hb, pb, tt0, len);
    }
}

DI void run_phase(int tid_o, int bid_o, KP p, LAS unsigned char* lds, int ph) {
    const float* MOD = (const float*)(p->ws + WS_MOD);

#ifndef DIS_PRO
    if (ph == 0) { prologue_phase(tid_o, bid_o, p, lds); return; }
#endif


#ifndef DIS_NORMF
    if (ph == 31) { norm_phase(tid_o, bid_o, p, 0, 0, false, true); return; }
#endif

    const int q = ph - 1, pair = q / 15, r = q % 15;
    const bool ab = r < 9;
    const int layer = pair * 2 + (ab ? 0 : 1), s = ab ? r : r - 9, i = pair;
    const int slot_n2 = ab ? 6 : 3;

#ifndef DIS_NORM
    if (s == 0) { norm_phase(tid_o, bid_o, p, layer, 0, layer == 0, false); return; }
    if (s == slot_n2) { norm_phase(tid_o, bid_o, p, layer, 1, false, false); return; }
#endif

    if (s == slot_n2 + 1) {
        pg8::Gemm g{(const bf16_t*)(p->ws + WS_DELTA), (const bf16_t*)(p->ws + WS_WFF1) + (size_t)layer * FF * 1024, 1024, 1024, 1024, 0, T / 256, FF / 256, 0, nullptr, nullptr, 0, 0, 0};
        Epi<EM_FF1> E{(bf16_t*)(p->ws + WS_FFH), nullptr, nullptr, nullptr, nullptr, nullptr, nullptr};

#ifndef DIS_FF1
        pg8::gemm_phase(tid_o, bid_o, lds, g, E);
#endif
        return;
    }
    if (s == slot_n2 + 2) {

        pg8::Gemm g{(const bf16_t*)(p->ws + WS_FFH), (const bf16_t*)(p->ws + WS_WFF2) + (size_t)layer * 1024 * FF, FF, FF, FF, 0, T / 256, 4, 0, nullptr, nullptr, 1, 1, 1};
        Epi<EM_RES> E{(bf16_t*)(p->ws + WS_H), nullptr, nullptr, nullptr, MOD + (size_t)layer * 5 * MODW + 5 * D, nullptr, nullptr};
#ifndef DIS_FF2
        pg8::gemm_phase(tid_o, bid_o, lds, g, E); return;
#else
        return;
#endif
    }
    if (ab) {
        if (s == 1) {
            pg8::Gemm g{(const bf16_t*)(p->ws + WS_DELTA), (const bf16_t*)(p->ws + WS_WIN) + (size_t)i * NZ * 1024, 1024, 1024, 1024, 0, T / 256, NZ / 256, 0, nullptr, nullptr, 0, 0, 0};
            Epi<EM_Z> E{(bf16_t*)(p->ws + WS_Z), nullptr, nullptr, nullptr, nullptr, nullptr, nullptr};
#ifndef DIS_ZIN
            pg8::gemm_phase(tid_o, bid_o, lds, g, E); return;
#else
            return;
#endif
        }
#ifndef DIS_ROWOP
        if (s == 2) { rowop_phase(tid_o, bid_o, p, i); return; }
#else
        if (s == 2) return;
#endif
        if (s == 3) {
            { pg8::Gemm g{(const bf16_t*)(p->ws + WS_QN), (const bf16_t*)(p->ws + WS_WQB) + (size_t)i * 768 * 384, 384, 384, 384, 0, T / 256, 3, 0, nullptr, nullptr, 0, 0, 0};
              Epi<EM_Q> E{(bf16_t*)(p->ws + WS_Q), nullptr, nullptr, nullptr, nullptr, nullptr, nullptr};
#ifndef DIS_Q
              pg8::gemm_phase(tid_o, bid_o, lds, g, E); }
#else
              }
#endif
            { pg8::Gemm g{(const bf16_t*)(p->ws + WS_CKV), (const bf16_t*)(p->ws + WS_WK) + (size_t)i * 512 * 256, 256, 256, 256, 0, KR / 256, 2, 224, nullptr, nullptr, 0, 0, 0};
              Epi<EM_K> E{(bf16_t*)(p->ws + WS_KF), nullptr, nullptr, nullptr, nullptr, nullptr, (const bf16_t*)(p->ws + WS_KPE)};
#ifndef DIS_K
              pg8::gemm_phase(tid_o, bid_o, lds, g, E); }
#else
              }
#endif
            { pg8::Gemm g{(const bf16_t*)(p->ws + WS_WV) + (size_t)i * 512 * 256, (const bf16_t*)(p->ws + WS_CKV), 256, 256, 256, 0, 2, KR / 256, 208, nullptr, nullptr, 0, 0, 0};
              Epi<EM_VT> E{(bf16_t*)(p->ws + WS_VT), nullptr, nullptr, nullptr, nullptr, nullptr, nullptr};
#ifndef DIS_V
              pg8::gemm_phase(tid_o, bid_o, lds, g, E); }
#else
              }
#endif
#ifndef DIS_SPAT
            spatial_phase(tid_o, bid_o, p, lds, i);
#else

#endif
            return;
        }
#ifndef DIS_ATTN
        if (s == 4) { attn_phase(tid_o, bid_o, p, lds); return; }
#else
        if (s == 4) return;
#endif
        if (s == 5) {
            pg8::Gemm g{(const bf16_t*)((unsigned char*)p->out), (const bf16_t*)(p->ws + WS_WOUT) + (size_t)i * 1024 * 1024, 1024, 1024, 1024, 0, T / 256, 4, 0, nullptr, nullptr, 0, 0, 1};
            Epi<EM_RES> E{(bf16_t*)(p->ws + WS_H), nullptr, nullptr, nullptr, MOD + (size_t)layer * 5 * MODW + 2 * D, nullptr, nullptr};
#ifndef DIS_OUT
            pg8::gemm_phase(tid_o, bid_o, lds, g, E); return;
#else
            return;
#endif
        }
    } else {
#ifndef DIS_PD
        if (s == 1) { pooldiff_phase(tid_o, bid_o, p); return; }
#else
        if (s == 1) return;
#endif
        if (s == 2) {
            pg8::Gemm g{(const bf16_t*)(p->ws + WS_PD), (const bf16_t*)(p->ws + WS_WPOOL) + (size_t)i * 1024 * 256, 1024, 256, 256, 256, T / 256, 4, 0, nullptr, nullptr, 0, 0, 1};
            Epi<EM_RES> E{(bf16_t*)(p->ws + WS_H), nullptr, nullptr, nullptr, MOD + (size_t)layer * 5 * MODW + 2 * D, p->in[I_PSCALE] + i * D, nullptr};
#ifndef DIS_POOL
            pg8::gemm_phase(tid_o, bid_o, lds, g, E); return;
#else
            return;
#endif
        }
    }
}


#define XB_TMO      128
#define XB_XCNT(j)  (256  + 64 * (j))
#define XB_XSUB(j)  (1280 + 64 * (j))
#define XB_XGEN(j)  (2304 + 64 * (j))
#define XB_TOP      3328
#define XB_TOPGEN   3392
#define XCD_BAR_WORDS 3456
#define XB_SPIN_CAP (1u << 22)
DI unsigned xb_ld(unsigned* p)              { return __hip_atomic_load(p, __ATOMIC_RELAXED, __HIP_MEMORY_SCOPE_AGENT); }
DI unsigned xb_add(unsigned* p, unsigned v) { return __hip_atomic_fetch_add(p, v, __ATOMIC_RELAXED, __HIP_MEMORY_SCOPE_AGENT); }
DI unsigned xb_xcc_id() { return (unsigned)__builtin_amdgcn_s_getreg((3 << 11) | 20) & 0xFu; }
#define XB_SPIN(cond, bar) do { unsigned _sp = 0; while (cond) { __builtin_amdgcn_s_sleep(1); \
    if ((++_sp & 255u) == 0u) { if (xb_ld(&(bar)[XB_TMO])) break; if (_sp > XB_SPIN_CAP) { atomicAdd(&(bar)[XB_TMO], 1u); break; } } } } while (0)
DI void xcd_barrier_complete(unsigned* bar, unsigned x, unsigned& nloc, unsigned& nx) {
    const unsigned G = gridDim.x;
    unsigned sum, cnt, mine, sp = 0u;
    for (;;) {
        sum = 0u; cnt = 0u; mine = 0u;
#pragma unroll
        for (unsigned j = 0; j < 16; ++j) { const unsigned c = xb_ld(&bar[XB_XCNT(j)]); sum += c; cnt += (c > 0u) ? 1u : 0u; mine = (j == x) ? c : mine; }
        if (sum == G) break;
        __builtin_amdgcn_s_sleep(1);
        if ((++sp & 255u) == 0u) { if (xb_ld(&bar[XB_TMO])) break; if (sp > XB_SPIN_CAP) { atomicAdd(&bar[XB_TMO], 1u); break; } }
    }
    nloc = mine > 0u ? mine : 1u; nx = cnt > 0u ? cnt : 1u;
}
DI void xcd_barrier(unsigned* bar, unsigned x, volatile LAS unsigned* st, int tid) {
    asm volatile("s_waitcnt vmcnt(0)" ::: "memory");
    __syncthreads();
    if (tid == 0) {
        __builtin_amdgcn_s_waitcnt(0);
        unsigned nloc = st[0], nx = st[1];
        if (nloc == 0u) { xcd_barrier_complete(bar, x, nloc, nx); st[0] = nloc; st[1] = nx; }
        const unsigned old = xb_add(&bar[XB_XSUB(x)], 1u);
        const unsigned gen = old / nloc;
        if (old + 1u == (gen + 1u) * nloc) {
            __builtin_amdgcn_fence(__ATOMIC_RELEASE, "agent");
            asm volatile("s_waitcnt vmcnt(0)" ::: "memory");
            const unsigned og = xb_add(&bar[XB_TOP], 1u);
            const unsigned tg = og / nx;
            if (og + 1u == (tg + 1u) * nx) xb_add(&bar[XB_TOPGEN], 1u);
            else XB_SPIN(xb_ld(&bar[XB_TOPGEN]) == tg, bar);
            __builtin_amdgcn_fence(__ATOMIC_ACQUIRE, "agent");
            xb_add(&bar[XB_XGEN(x)], 1u);
            asm volatile("s_waitcnt vmcnt(0)" ::: "memory");
        } else {
            XB_SPIN(xb_ld(&bar[XB_XGEN(x)]) == gen, bar);
            __builtin_amdgcn_fence(__ATOMIC_ACQUIRE, "agent");
            asm volatile("s_waitcnt vmcnt(0)" ::: "memory");
        }
    }
    __syncthreads();
}

#ifndef REPMASK
#define REPMASK 0
#endif
DI int phase_class(int ph) {
    if (ph == 0) return 0;
    if (ph == 31) return 15;
    const int q = ph - 1, r = q % 15; const bool ab = r < 9; const int s = ab ? r : r - 9, n2 = ab ? 6 : 3;
    if (s == 0 || s == n2) return 1;
    if (s == n2 + 1) return 7;
    if (s == n2 + 2) return 15;
    if (ab) { if (s == 1) return 2; if (s == 2) return 3; if (s == 3) return 4; if (s == 4) return 5; if (s == 5) return ph == 6 ? 6 : 15; }
    else { if (s == 1) return 8; }
    return 15;
}
__global__ void __launch_bounds__(512, 2) fwd_megakernel(Params p) {
    extern __shared__ __attribute__((aligned(16))) unsigned char smem[];
    LAS unsigned char* lds = (LAS unsigned char*)smem;
    volatile LAS unsigned* xst = (volatile LAS unsigned*)(lds + XST_OFF);
    unsigned* bar = (unsigned*)(p.ws + WS_CTL);
    const unsigned xcc = xb_xcc_id();
    if (p.coop) {
        if (threadIdx.x == 0) { xst[0] = 0u; xst[1] = 0u; (void)xb_add(&bar[XB_XCNT(xcc)], 1u); }
        __syncthreads();
    }
    if (p.ph_lo < 0) cg::this_grid().sync();
    for (int ph = p.ph_lo; ph < p.ph_hi; ++ph) {
#if REPMASK
        const int reps = 1 + ((REPMASK >> phase_class(ph)) & 1);
#else
        const int reps = 1;
#endif
#pragma nounroll
        for (int rep = 0; rep < reps; ++rep) {
            int tid_o = (int)__builtin_amdgcn_workitem_id_x(), bid_o = (int)__builtin_amdgcn_workgroup_id_x();
            asm volatile("" : "+v"(tid_o)); asm volatile("" : "+s"(bid_o));
            KP kp = (KP)__builtin_amdgcn_kernarg_segment_ptr(); asm volatile("" : "+s"(kp));
            run_phase(tid_o, bid_o, kp, lds, ph);
            if (rep + 1 < reps || ph + 1 < p.ph_hi) xcd_barrier(bar, xcc, xst, tid_o);
        }
    }
}

extern "C" void kernel_launch(void* const* d_in, const int* in_sizes, int n_in, void* d_out, int out_size, void* d_ws, size_t ws_size, hipStream_t stream) {
    static int grid = 0;
    if (grid == 0) {
        if (n_in != 24 || ws_size < WS_TOTAL) { fprintf(stderr, "kernel_launch: unexpected n_in %d / ws_size %zu (need %zu)\n", n_in, ws_size, (size_t)WS_NEED); grid = -1; return; }
        int dev = 0, cus = 0, per_cu = 0;
        hipGetDevice(&dev);
        hipDeviceGetAttribute(&cus, hipDeviceAttributeMultiprocessorCount, dev);
        if (hipFuncSetAttribute((const void*)fwd_megakernel, hipFuncAttributeMaxDynamicSharedMemorySize, LDS_BYTES) != hipSuccess) { fprintf(stderr, "kernel_launch: hipFuncSetAttribute failed\n"); grid = -1; return; }
        if (hipOccupancyMaxActiveBlocksPerMultiprocessor(&per_cu, (const void*)fwd_megakernel, 512, LDS_BYTES) != hipSuccess || per_cu < 1) { fprintf(stderr, "kernel_launch: occupancy query gave %d\n", per_cu); per_cu = 1; (void)hipGetLastError(); }
        grid = cus * 1;
        if (grid <= 0) grid = 256;
    }
    if (grid < 0) return;
    Params p{};
    for (int i = 0; i < 24; ++i) p.in[i] = (const float*)d_in[i];
    p.out = (float*)d_out; p.ws = (unsigned char*)d_ws;
#if MK_COOP
    p.ph_lo = 0; p.ph_hi = NPHASE; p.coop = 1;
    (void)hipMemsetAsync((char*)d_ws + WS_CTL, 0, CTL_BYTES, stream);
    void* args[] = {&p};
    hipError_t e = hipLaunchCooperativeKernel((const void*)fwd_megakernel, dim3(grid), dim3(512), args, LDS_BYTES, stream);
    if (e != hipSuccess) fprintf(stderr, "cooperative launch failed: %s (grid %d)\n", hipGetErrorString(e), grid);
#else
    for (int ph = 0; ph < NPHASE; ++ph) {
        p.ph_lo = ph; p.ph_hi = ph + 1;
        hipLaunchKernelGGL(fwd_megakernel, dim3(grid), dim3(512), LDS_BYTES, stream, p);
    }
#endif
}
```

```cpp
#include <hip/hip_runtime.h>
#include <hip/hip_cooperative_groups.h>
#include <cstdio>
#include <cstdint>
namespace cg = cooperative_groups;

#ifndef MK_COOP
#define MK_COOP 1
#endif

#define DI __device__ __forceinline__
#define LAS __attribute__((address_space(3)))
typedef unsigned short bf16_t;
typedef short bf16x8 __attribute__((ext_vector_type(8)));
typedef float f32x2 __attribute__((ext_vector_type(2)));
typedef float f32x4 __attribute__((ext_vector_type(4)));
typedef float f32x16 __attribute__((ext_vector_type(16)));
typedef unsigned u32x2 __attribute__((ext_vector_type(2)));
typedef unsigned u32x4 __attribute__((ext_vector_type(4)));
typedef __bf16 bf16x2_t __attribute__((ext_vector_type(2)));

constexpr int D = 1024, T_CTX = 8192, T_LAT = 16384, T = T_CTX + T_LAT;
constexpr int LLAT = 4608, KR = T_CTX + 4 * LLAT;
constexpr int NZ = 1792, FF = 4096;
constexpr int MODW = 6144;
constexpr float EPS = 1e-6f;
constexpr float QSCALE = 0.10206207261596577f * 1.4426950408889634f;
constexpr size_t OUT_CKV = (size_t)T * D, OUT_KPE = OUT_CKV + (size_t)32 * 2 * 256 * 256;
constexpr size_t KF_CTX = (size_t)32 * 8 * 256 * 96, VT_CTX = (size_t)32 * 8 * 64 * 256;

constexpr size_t WS_WIN = 0;
constexpr size_t WS_WQB = WS_WIN + (size_t)2 * NZ * 1024 * 2;
constexpr size_t WS_WK = WS_WQB + (size_t)2 * 768 * 384 * 2;
constexpr size_t WS_WV = WS_WK + (size_t)2 * 512 * 256 * 2;
constexpr size_t WS_WOUT = WS_WV + (size_t)2 * 512 * 256 * 2;
constexpr size_t WS_WPOOL = WS_WOUT + (size_t)2 * 1024 * 1024 * 2;
constexpr size_t WS_WSP = WS_WPOOL + (size_t)2 * 1024 * 256 * 2;
constexpr size_t WS_WFF1 = WS_WSP + (size_t)2 * 8 * 128 * 128 * 2;
constexpr size_t WS_WFF2 = WS_WFF1 + (size_t)4 * FF * 1024 * 2;
constexpr size_t WS_MOD = WS_WFF2 + (size_t)4 * FF * 1024 * 2;
constexpr size_t WS_H = WS_MOD + (size_t)4 * 5 * MODW * 4;
constexpr size_t WS_U = WS_H + (size_t)T * 1024 * 2;
constexpr size_t WS_Z = WS_U;
constexpr size_t WS_QN = WS_Z + (size_t)T * NZ * 2;
constexpr size_t WS_CKV = WS_QN + (size_t)T * 384 * 2;
constexpr size_t WS_Q = WS_CKV + (size_t)KR * 256 * 2;
constexpr size_t WS_KF = WS_Q + (size_t)T * 768 * 2;
constexpr size_t WS_VT = WS_KF + (size_t)KR * 8 * 96 * 2;
constexpr size_t WS_VN = WS_VT + (size_t)KR * 512 * 2;
constexpr size_t WS_END1 = WS_VN + (size_t)T * 512 * 2;
constexpr size_t WS_FFH = WS_U;
constexpr size_t WS_PD = WS_U;
constexpr size_t WS_END2 = WS_FFH + (size_t)T * FF * 2;
constexpr size_t WS_DELTA = WS_END2;
static_assert(WS_DELTA + (size_t)T * 1024 * 2 <= WS_END1, "delta");
constexpr size_t WS_NEED = WS_END1 > WS_END2 ? WS_END1 : WS_END2;
static_assert(WS_NEED <= (size_t)402653184, "workspace map exceeds 4x largest tensor");

constexpr int XST_OFF = 131072;
constexpr int LDS_BYTES = 131072 + 64;
constexpr size_t WS_CTL = (WS_NEED + 255) & ~(size_t)255, CTL_BYTES = 32768;
constexpr size_t WS_KPE = WS_CTL + CTL_BYTES;
constexpr size_t WS_TOTAL = WS_KPE + (size_t)KR * 32 * 2;
static_assert(WS_TOTAL <= (size_t)402653184, "ctl");
constexpr int NPHASE = 32;

struct Params {
    const float* in[24];
    float* out;
    unsigned char* ws;
    int ph_lo, ph_hi;
    int coop, pad;
};
typedef const __attribute__((address_space(4))) Params* KP;
enum { I_XP = 0, I_XS, I_CCKV, I_CKPE, I_C, I_CCTX, I_WMOD, I_BMOD, I_N1G, I_N2G, I_WIN, I_QAG, I_KVAG, I_WQB, I_WKVB, I_VG, I_WSP, I_BSP, I_WOUT, I_WPOOL, I_PSCALE, I_WFF1, I_WFF2, I_FG };

DI unsigned pk_bf16(float lo, float hi) { f32x2 v = {lo, hi}; bf16x2_t b = __builtin_convertvector(v, bf16x2_t); return __builtin_bit_cast(unsigned, b); }
DI float bf_lo(unsigned u) { return __builtin_bit_cast(float, u << 16); }
DI float bf_hi(unsigned u) { return __builtin_bit_cast(float, u & 0xffff0000u); }
DI float bf1(bf16_t u) { return __builtin_bit_cast(float, (unsigned)u << 16); }
DI bf16_t f2bf(float f) { return (bf16_t)(pk_bf16(f, 0.f) & 0xffffu); }
DI float wave_sum(float v) {
#pragma unroll
    for (int o = 32; o; o >>= 1) v += __shfl_xor(v, o);
    return v;
}
DI int cond_of_row(int row) { return row < T_CTX ? 4 : ((row - T_CTX) >> 12); }
DI void sincos_rr(float x, float& s, float& c) {
    const float n = rintf(x * 0.15915494309189535f);
    float r = fmaf(-n, 6.2831854820251465f, x);
    r = fmaf(-n, -1.7484556000744883e-07f, r);
    s = __sinf(r); c = __cosf(r);
}
DI float rope_inv(int f) { return exp2f(-(float)f * 1.6609640474436813f); }
DI float gelu_tanh(float x) {
    const float u = 0.7978845608028654f * (x + 0.044715f * x * x * x);
    const float t = __builtin_amdgcn_exp2f(-2.885390081777927f * u);
    return x * __builtin_amdgcn_rcpf(1.f + t);
}

namespace pg8 {
constexpr int BM = 256, BK = 64, HALF = 128, HTB = HALF * BK * 2, NXCD = 8, WGM = 8;
DI int lds_byte(int r, int c) { const int st = (r >> 4) * 2 + (c >> 5), rr = r & 15, cc = c & 31, ob = rr * 64 + cc * 2; return st * 1024 + (ob ^ (((ob >> 9) & 1) << 5)); }
DI void stage_rc(int b, int& R, int& C) { const int st = b / 1024, sb = b % 1024, swz = sb ^ (((sb >> 9) & 1) << 5); R = (st >> 1) * 16 + swz / 64; C = (st & 1) * 32 + (swz % 64) / 2; }
DI int perm32(int rho) { const int n = rho >> 4, i = rho & 15; return 8 * (i >> 2) + 4 * n + (i & 3); }
struct Unit { int pm, pn, kt0, nt, role, slot, mh; };
struct Gemm { const bf16_t* A; const bf16_t* Bt; int lda, ldb, K, a_pn_step, nM, nN, rot; float* P; unsigned* flags; int tiledA, tiledB, msplit; };

DI bool next_unit(int bid_o, const Gemm& g, int i, Unit& u) {
    const int G = gridDim.x; int c = bid_o + g.rot; if (c >= G) c -= G;
    const int nwg = g.nM * g.nN, ntf = g.K / BK;
    const int R = nwg / G, r = nwg - R * G;
    const bool split = g.P != nullptr && r > 0 && 2 * r <= G;
    long L; u.kt0 = 0; u.nt = ntf; u.role = 0; u.slot = 0; u.mh = 0;
    const bool msp = g.msplit && r > 0 && 2 * r <= G;
    if (msp) {
        if (i < R) L = (long)i * G + c;
        else if (i == R && c < 2 * r) { L = (long)R * G + (c >> 1); u.mh = 1 + (c & 1); }
        else return false;
    } else
    if (split && c < 2 * r) {
        const bool prod = (c & 1) == 0;
        if (i > R) return false;
        if (prod ? (i == 0) : (i == R)) { L = (long)R * G + (c >> 1); u.nt = ntf / 2; u.kt0 = prod ? 0 : ntf / 2; u.role = prod ? 1 : 2; u.slot = c >> 1; }
        else L = (long)(prod ? i - 1 : i) * G + c;
    } else {
        L = (long)i * G + c;
        if (split ? (i >= R) : (L >= nwg)) return false;
    }
    int wgid = (int)L; { const int q = nwg / NXCD, rr = nwg % NXCD, xcd = wgid % NXCD, off = wgid / NXCD; wgid = (xcd < rr ? xcd * (q + 1) : rr * (q + 1) + (xcd - rr) * q) + off; }
    const int nig = WGM * g.nN, gid = wgid / nig, fm = gid * WGM, gsz = (g.nM - fm) < WGM ? (g.nM - fm) : WGM;
    u.pm = fm + ((wgid % nig) % gsz); u.pn = (wgid % nig) / gsz; return true;
}

template <class EpiT>
DI void gemm_phase(int tid_o, int bid_o, LAS unsigned char* lds, const Gemm g, const EpiT& E) {
    const int tid = tid_o, wid = __builtin_amdgcn_readfirstlane(tid >> 6), lane = tid & 63, wr = wid >> 2, wc = wid & 3, fr = lane & 15, fq = lane >> 4;
    const int ldaE = g.tiledA ? 64 : g.lda, ldbE = g.tiledB ? 64 : g.ldb;
    unsigned voffA[2], voffB[2];
#pragma unroll
    for (int i = 0; i < 2; ++i) { int R, C; stage_rc(tid * 16 + i * 8192, R, C); const int Rb = (R & ~31) + perm32(R & 31);
        voffA[i] = (unsigned)(R * ldaE + C) * 2u; voffB[i] = (unsigned)(Rb * ldbE + C) * 2u; }
    const size_t kstepA = g.tiledA ? 32768 : 128, kstepB = g.tiledB ? 32768 : 128;
    const size_t hstepA = (size_t)HALF * ldaE * 2, hstepB = (size_t)HALF * ldbE * 2;
    const size_t tstepA = g.tiledA ? (size_t)512 * g.K : 2 * hstepA, tstepB = g.tiledB ? (size_t)512 * g.K : 2 * hstepB;
    const unsigned ldsw = (unsigned)wid * 1024u;
    const int aoff = lds_byte(wr * 64 + fr, fq * 8), boff = lds_byte(wc * 32 + fr, fq * 8);
#define PG8_SA(b, h) (((b) * 2 + (h)) * HTB)
#define PG8_SB(b, h) ((4 + (b) * 2 + (h)) * HTB)
#define PG8_STAGE(bufoff, gbase, voff) do { _Pragma("unroll") for (int _i = 0; _i < 2; ++_i) \
        __builtin_amdgcn_global_load_lds((const unsigned*)((const char*)(gbase) + (voff)[_i]), (LAS unsigned*)(lds + (bufoff) + ldsw + _i * 8192), 16, 0, 0); } while (0)
#define PG8_LDA(dst, b, h) do { _Pragma("unroll") for (int m = 0; m < 4; ++m) _Pragma("unroll") for (int k = 0; k < 2; ++k) dst[m][k] = *(const LAS bf16x8*)(lds + PG8_SA(b, h) + aoff + m * 2048 + k * 1024); } while (0)
#define PG8_LDB(dst, b, h) do { _Pragma("unroll") for (int n = 0; n < 2; ++n) _Pragma("unroll") for (int k = 0; k < 2; ++k) dst[n][k] = *(const LAS bf16x8*)(lds + PG8_SB(b, h) + boff + n * 2048 + k * 1024); } while (0)
#define PG8_MMA(ai, bj, At, Bt) do { __builtin_amdgcn_s_setprio(1); _Pragma("unroll") for (int m = 0; m < 4; ++m) _Pragma("unroll") for (int n = 0; n < 2; ++n) _Pragma("unroll") for (int k = 0; k < 2; ++k) \
        acc[ai][bj][m][n] = __builtin_amdgcn_mfma_f32_16x16x32_bf16(Bt[n][k], At[m][k], acc[ai][bj][m][n], 0, 0, 0); __builtin_amdgcn_s_setprio(0); } while (0)
#define PG8_WAIT_V(n) asm volatile("s_waitcnt vmcnt(" #n ")" ::: "memory")
#define PG8_WAIT_L(n) asm volatile("s_waitcnt lgkmcnt(" #n ")" ::: "memory")
#define PG8_BAR __builtin_amdgcn_s_barrier()
#define PG8_SCHED __builtin_amdgcn_sched_barrier(0)
    Unit cur, nxt; int ui = 0;
    if (!next_unit(bid_o, g, 0, cur)) return;
    f32x4 acc[2][2][4][2];
#pragma unroll
    for (int a = 0; a < 2; ++a)
#pragma unroll
        for (int b = 0; b < 2; ++b)
#pragma unroll
            for (int m = 0; m < 4; ++m)
#pragma unroll
                for (int n = 0; n < 2; ++n) acc[a][b][m][n] = (f32x4){0.f, 0.f, 0.f, 0.f};
    bf16x8 At[4][2], B0[2][2], B1[2][2];
    const char* cA = (const char*)g.A + (size_t)cur.pm * tstepA + (size_t)cur.pn * g.a_pn_step * 2 + (size_t)cur.kt0 * kstepA + (cur.mh == 2 ? hstepA : 0); const char* cB = (const char*)g.Bt + (size_t)cur.pn * tstepB + (size_t)cur.kt0 * kstepB;
    PG8_STAGE(PG8_SB(0, 0), cB, voffB); PG8_STAGE(PG8_SB(0, 1), cB + hstepB, voffB); PG8_STAGE(PG8_SA(0, 0), cA, voffA); PG8_STAGE(PG8_SA(0, 1), cA + (cur.mh ? 0 : hstepA), voffA);
    if (wr == 1) PG8_BAR;
    PG8_WAIT_V(2); PG8_BAR;
    PG8_STAGE(PG8_SB(1, 0), cB + kstepB, voffB); PG8_STAGE(PG8_SA(1, 0), cA + kstepA, voffA); PG8_STAGE(PG8_SB(1, 1), cB + hstepB + kstepB, voffB);
    PG8_WAIT_V(6); PG8_BAR;
    for (;;) {
        const bool has_next = next_unit(bid_o, g, ui + 1, nxt);
        const char* nA = has_next ? (const char*)g.A + (size_t)nxt.pm * tstepA + (size_t)nxt.pn * g.a_pn_step * 2 + (size_t)nxt.kt0 * kstepA + (nxt.mh == 2 ? hstepA : 0) : cA;
        const size_t hAc = cur.mh ? 0 : hstepA, hAn = has_next ? (nxt.mh ? 0 : hstepA) : hAc;
        const bool fullM = cur.mh == 0; const char* nB = has_next ? (const char*)g.Bt + (size_t)nxt.pn * tstepB + (size_t)nxt.kt0 * kstepB : cB;
        const int nt = cur.nt;
#pragma nounroll
        for (int t = 0; t < nt; t += 2) {
            const bool last = (t == nt - 2);
            const char* a1 = cA + (size_t)(t + 1) * kstepA;
            const char* a2 = last ? nA : cA + (size_t)(t + 2) * kstepA; const char* b2 = last ? nB : cB + (size_t)(t + 2) * kstepB;
            const char* a3 = a2 + kstepA; const char* b3 = b2 + kstepB;
            PG8_LDB(B0, 0, 0); PG8_LDB(B1, 0, 1); PG8_SCHED; PG8_LDA(At, 0, 0); PG8_STAGE(PG8_SA(1, 1), a1 + hAc, voffA);
            PG8_WAIT_V(8); PG8_WAIT_L(0); PG8_BAR; PG8_MMA(0, 0, At, B0); PG8_MMA(0, 1, At, B1); PG8_BAR; PG8_SCHED;
            PG8_LDA(At, 0, 1); PG8_STAGE(PG8_SB(0, 0), b2, voffB); PG8_STAGE(PG8_SB(0, 1), b2 + hstepB, voffB); PG8_STAGE(PG8_SA(0, 0), a2, voffA);
            PG8_WAIT_V(8); PG8_WAIT_L(0); PG8_BAR; if (fullM) { PG8_MMA(1, 0, At, B0); PG8_MMA(1, 1, At, B1); } PG8_BAR; PG8_SCHED;
            PG8_LDB(B0, 1, 0); PG8_LDB(B1, 1, 1); PG8_SCHED; PG8_LDA(At, 1, 0); PG8_STAGE(PG8_SA(0, 1), a2 + (last ? hAn : hAc), voffA);
            PG8_WAIT_V(8); PG8_WAIT_L(0); PG8_BAR; PG8_MMA(0, 0, At, B0); PG8_MMA(0, 1, At, B1); PG8_BAR; PG8_SCHED;
            PG8_LDA(At, 1, 1); PG8_STAGE(PG8_SB(1, 0), b3, voffB); PG8_STAGE(PG8_SB(1, 1), b3 + hstepB, voffB); PG8_STAGE(PG8_SA(1, 0), a3, voffA);
            PG8_WAIT_V(8); PG8_WAIT_L(0); PG8_BAR; if (fullM) { PG8_MMA(1, 0, At, B0); PG8_MMA(1, 1, At, B1); } PG8_BAR; PG8_SCHED;
        }
        if (wr == 0) PG8_BAR;
        if (cur.role == 1) {
            float* pp = g.P + (size_t)cur.slot * 65536 + tid * 4;
#pragma unroll
            for (int a = 0; a < 2; ++a)
#pragma unroll
                for (int b = 0; b < 2; ++b)
#pragma unroll
                    for (int m = 0; m < 4; ++m)
#pragma unroll
                        for (int n = 0; n < 2; ++n) *(f32x4*)(pp + (size_t)(((a * 2 + b) * 4 + m) * 2 + n) * 2048) = acc[a][b][m][n];
            asm volatile("s_waitcnt vmcnt(0)" ::: "memory");
            __syncthreads();
            if (tid == 0) { __builtin_amdgcn_fence(__ATOMIC_RELEASE, "agent"); asm volatile("s_waitcnt vmcnt(0)" ::: "memory"); __hip_atomic_fetch_add(g.flags + cur.slot, 1u, __ATOMIC_RELAXED, __HIP_MEMORY_SCOPE_AGENT); }
        } else {
            if (cur.role == 2) {
                if (tid == 0) {
                    unsigned sp = 0;
                    while (__hip_atomic_load(g.flags + cur.slot, __ATOMIC_RELAXED, __HIP_MEMORY_SCOPE_AGENT) == 0u) { __builtin_amdgcn_s_sleep(1); if (++sp > (1u << 24)) break; }
                    __builtin_amdgcn_fence(__ATOMIC_ACQUIRE, "agent"); asm volatile("s_waitcnt vmcnt(0)" ::: "memory");
                }
                __syncthreads();
            }
            E(acc, cur, wr, wc, fr, fq, cur.role == 2 ? g.P + (size_t)cur.slot * 65536 + tid * 4 : (const float*)nullptr);
        }
        if (!has_next) break;
#pragma unroll
        for (int a = 0; a < 2; ++a)
#pragma unroll
            for (int b = 0; b < 2; ++b)
#pragma unroll
                for (int m = 0; m < 4; ++m)
#pragma unroll
                    for (int n = 0; n < 2; ++n) acc[a][b][m][n] = (f32x4){0.f, 0.f, 0.f, 0.f};
        cur = nxt; cA = nA; cB = nB; ++ui;
        if (wr == 1) PG8_BAR;
    }
    PG8_WAIT_V(0);
    PG8_BAR;
#undef PG8_SA
#undef PG8_SB
#undef PG8_STAGE
#undef PG8_LDA
#undef PG8_LDB
#undef PG8_MMA
#undef PG8_WAIT_V
#undef PG8_WAIT_L
#undef PG8_BAR
#undef PG8_SCHED
}
}

enum { EM_Z = 0, EM_Q, EM_K, EM_VT, EM_RES, EM_FF1 };
template <int mode> struct Epi {
    bf16_t* O;
    float* X;
    const float* xin0; const float* xin1;
    const float* gate;
    const float* cscale;
    const bf16_t* kpe;
    DI void operator()(const f32x4 (&acc)[2][2][4][2], const pg8::Unit& u, int wr, int wc, int fr, int fq, const float* part) const {
        const int row0 = u.pm * 256 + wr * 64 + fr;
        const int col0 = u.pn * 256 + wc * 32 + 8 * fq;
        if (mode == EM_Z || mode == EM_FF1) {
            const int ld = mode == EM_Z ? NZ : FF;
            const bool gel = (mode == EM_Z) && (u.pn >= 3);
            const bool sq = (mode == EM_FF1);
#pragma unroll
            for (int ai = 0; ai < 2; ++ai)
#pragma unroll
                for (int m = 0; m < 4; ++m) {
                    bf16_t* rowp = sq ? O + (size_t)u.pm * 256 * FF + (size_t)(u.pn * 4 + (wc >> 1)) * 16384 + (size_t)(wr * 64 + fr + ai * 128 + m * 16) * 64 + (wc & 1) * 32 + 8 * fq
                                     : O + (size_t)(row0 + ai * 128 + m * 16) * ld + col0;
#pragma unroll
                    for (int bj = 0; bj < 2; ++bj) {
                        f32x4 v0 = acc[ai][bj][m][0], v1 = acc[ai][bj][m][1];
                        if (gel) {
#pragma unroll
                            for (int e = 0; e < 4; ++e) { v0[e] = gelu_tanh(v0[e]); v1[e] = gelu_tanh(v1[e]); }
                        }
                        if (sq) {
#pragma unroll
                            for (int e = 0; e < 4; ++e) { float a = fmaxf(v0[e], 0.f), b = fmaxf(v1[e], 0.f); v0[e] = a * a; v1[e] = b * b; }
                        }
                        u32x4 w; w.x = pk_bf16(v0[0], v0[1]); w.y = pk_bf16(v0[2], v0[3]); w.z = pk_bf16(v1[0], v1[1]); w.w = pk_bf16(v1[2], v1[3]);
                        *(u32x4*)(rowp + (sq ? bj * 2 * 16384 : bj * 128)) = w;
                    }
                }
        } else if (mode == EM_Q) {
#pragma unroll
            for (int bj = 0; bj < 2; ++bj) {
                const int c = col0 + bj * 128;
                const int j0 = c % 96;
                const bool rope_cols = j0 >= 64;
                const int jj0 = j0 - 64, ax = jj0 >> 4, fbase = (jj0 & 15) >> 1;
                float inv[4];
#pragma unroll
                for (int e = 0; e < 4; ++e) inv[e] = rope_inv(fbase + e);
#pragma unroll
                for (int ai = 0; ai < 2; ++ai)
#pragma unroll
                    for (int m = 0; m < 4; ++m) {
                        const int row = row0 + ai * 128 + m * 16;
                        f32x4 v0 = acc[ai][bj][m][0] * QSCALE, v1 = acc[ai][bj][m][1] * QSCALE;
                        if (rope_cols && row >= T_CTX) {
                            const int tt = (row - T_CTX) & 4095;
                            const float pos = (float)(ax == 0 ? (tt >> 6) : (tt & 63));
                            float s, cs, a, b;
                            sincos_rr(pos * inv[0], s, cs); a = v0[0]; b = v0[1]; v0[0] = a * cs - b * s; v0[1] = b * cs + a * s;
                            sincos_rr(pos * inv[1], s, cs); a = v0[2]; b = v0[3]; v0[2] = a * cs - b * s; v0[3] = b * cs + a * s;
                            sincos_rr(pos * inv[2], s, cs); a = v1[0]; b = v1[1]; v1[0] = a * cs - b * s; v1[1] = b * cs + a * s;
                            sincos_rr(pos * inv[3], s, cs); a = v1[2]; b = v1[3]; v1[2] = a * cs - b * s; v1[3] = b * cs + a * s;
                        }
                        u32x4 w; w.x = pk_bf16(v0[0], v0[1]); w.y = pk_bf16(v0[2], v0[3]); w.z = pk_bf16(v1[0], v1[1]); w.w = pk_bf16(v1[2], v1[3]);
                        *(u32x4*)(O + (size_t)row * 768 + c) = w;
                    }
            }
        } else if (mode == EM_K) {
            const int kr0 = u.pm * 256;
            size_t base; int L, l0;
            if (kr0 < T_CTX) { const int b = kr0 >> 8; L = 256; l0 = 0; base = (size_t)b * 8 * 256 * 96; }
            else { const int kk = kr0 - T_CTX, b = kk / LLAT; L = LLAT; l0 = kk - b * LLAT; base = KF_CTX + (size_t)b * 8 * LLAT * 96; }
#pragma unroll
            for (int bj = 0; bj < 2; ++bj) {
                const int c = col0 + bj * 128, h = c >> 6, j = c & 63;
#pragma unroll
                for (int ai = 0; ai < 2; ++ai)
#pragma unroll
                    for (int m = 0; m < 4; ++m) {
                        const int l = l0 + wr * 64 + fr + ai * 128 + m * 16;
                        const f32x4 v0 = acc[ai][bj][m][0], v1 = acc[ai][bj][m][1];
                        u32x4 w; w.x = pk_bf16(v0[0], v0[1]); w.y = pk_bf16(v0[2], v0[3]); w.z = pk_bf16(v1[0], v1[1]); w.w = pk_bf16(v1[2], v1[3]);
                        *(u32x4*)(O + base + ((size_t)h * L + l) * 96 + j) = w;
                    }
            }
            {
                const int tid = (wr * 4 + wc) * 64 + fq * 16 + fr;
#pragma unroll
                for (int q2 = 0; q2 < 2; ++q2) {
                    const int pr = tid + 512 * q2, r = pr & 255, h = u.pn * 4 + (pr >> 8);
                    const u32x4* src = (const u32x4*)(kpe + (size_t)(kr0 + r) * 32);
                    u32x4* dst = (u32x4*)(O + base + ((size_t)h * L + l0 + r) * 96 + 64);
                    const u32x4 c0 = src[0], c1 = src[1], c2 = src[2], c3 = src[3];
                    dst[0] = c0; dst[1] = c1; dst[2] = c2; dst[3] = c3;
                }
            }
        } else if (mode == EM_VT) {
            const int kr0 = u.pn * 256;
            size_t base; int L, l0;
            if (kr0 < T_CTX) { const int b = kr0 >> 8; L = 256; l0 = 0; base = (size_t)b * 8 * 64 * 256; }
            else { const int kk = kr0 - T_CTX, b = kk / LLAT; L = LLAT; l0 = kk - b * LLAT; base = VT_CTX + (size_t)b * 8 * 64 * LLAT; }
#pragma unroll
            for (int ai = 0; ai < 2; ++ai)
#pragma unroll
                for (int m = 0; m < 4; ++m) {
                    const int f = row0 + ai * 128 + m * 16;
#pragma unroll
                    for (int bj = 0; bj < 2; ++bj) {
                        const int l = l0 + wc * 32 + 8 * fq + bj * 128;
                        const f32x4 v0 = acc[ai][bj][m][0], v1 = acc[ai][bj][m][1];
                        u32x4 w; w.x = pk_bf16(v0[0], v0[1]); w.y = pk_bf16(v0[2], v0[3]); w.z = pk_bf16(v1[0], v1[1]); w.w = pk_bf16(v1[2], v1[3]);
                        *(u32x4*)(O + base + (size_t)f * L + l) = w;
                    }
                }
        } else {
            typedef _Float16 h16x8_t __attribute__((ext_vector_type(8)));
            typedef float f32x8_t __attribute__((ext_vector_type(8)));
            _Float16* X = (_Float16*)O;
            const int b = cond_of_row(u.pm * 256);
            const float* gp = gate + (size_t)b * MODW;
#pragma unroll
            for (int bj = 0; bj < 2; ++bj) {
                const int c = col0 + bj * 128;
                f32x4 g0 = *(const f32x4*)(gp + c), g1 = *(const f32x4*)(gp + c + 4);
                if (cscale) { g0 = g0 * *(const f32x4*)(cscale + c); g1 = g1 * *(const f32x4*)(cscale + c + 4); }
                h16x8_t xv[2][4];
#pragma unroll
                for (int ai = 0; ai < 2; ++ai)
#pragma unroll
                    for (int m = 0; m < 4; ++m) {
                        if (ai == 1 && u.mh) continue;
                        const int row = row0 + (u.mh == 2 ? 128 : 0) + ai * 128 + m * 16;
                        xv[ai][m] = *(const h16x8_t*)(X + (size_t)row * D + c);
                    }
#pragma unroll
                for (int ai = 0; ai < 2; ++ai)
#pragma unroll
                    for (int m = 0; m < 4; ++m) {
                        if (ai == 1 && u.mh) continue;
                        const int row = row0 + (u.mh == 2 ? 128 : 0) + ai * 128 + m * 16;
                        const f32x4 a0 = acc[ai][bj][m][0] * g0, a1 = acc[ai][bj][m][1] * g1;
                        f32x8_t xf = __builtin_convertvector(xv[ai][m], f32x8_t);
                        xf[0] += a0[0]; xf[1] += a0[1]; xf[2] += a0[2]; xf[3] += a0[3]; xf[4] += a1[0]; xf[5] += a1[1]; xf[6] += a1[2]; xf[7] += a1[3];
                        *(h16x8_t*)(X + (size_t)row * D + c) = __builtin_convertvector(xf, h16x8_t);
                    }
            }
        }
    }
};

struct TDesc { const float* src; bf16_t* dst; int ld, K, N, perm, tiled; };
DI int tperm(int perm, int n) {
    if (perm == 0) return n;
    if (perm == 1) return n < 672 ? n : (n < 768 ? -1 : n - 96);
    if (perm == 2) { const int h = n / 96, j = n - h * 96; if (j < 64) return n; const int jj = j - 64, a = jj >> 4, r = jj & 15, f = r >> 1, pp = r & 1; return h * 96 + 64 + a * 16 + pp * 8 + f; }
    if (perm == 3) return (n >> 6) * 128 + (n & 63);
    return (n >> 6) * 128 + 64 + (n & 63);
}
DI bool tdesc_find(KP p, int tile, TDesc& d, int& local) {
    int t = tile;
#define TD_TRY(SRC, DST, LD, KK, NN, PERM) { const int cnt = ((KK) / 64) * ((NN) / 32); if (t < cnt) { d.src = (SRC); d.dst = (DST); d.ld = (LD); d.K = (KK); d.N = (NN); d.perm = (PERM) & 15; d.tiled = (PERM) >> 4; local = t; return true; } t -= cnt; }
    for (int i = 0; i < 4; ++i) TD_TRY(p->in[I_WFF1] + (size_t)i * 1024 * FF, (bf16_t*)(p->ws + WS_WFF1) + (size_t)i * FF * 1024, FF, 1024, FF, 0)
    for (int i = 0; i < 4; ++i) TD_TRY(p->in[I_WFF2] + (size_t)i * FF * 1024, (bf16_t*)(p->ws + WS_WFF2) + (size_t)i * 1024 * FF, 1024, FF, 1024, 16)
    for (int i = 0; i < 2; ++i) TD_TRY(p->in[I_WIN] + (size_t)i * 1024 * 1696, (bf16_t*)(p->ws + WS_WIN) + (size_t)i * NZ * 1024, 1696, 1024, NZ, 1)
    for (int i = 0; i < 2; ++i) TD_TRY(p->in[I_WOUT] + (size_t)i * 1024 * 1024, (bf16_t*)(p->ws + WS_WOUT) + (size_t)i * 1024 * 1024, 1024, 1024, 1024, 0)
    for (int i = 0; i < 2; ++i) TD_TRY(p->in[I_WQB] + (size_t)i * 384 * 768, (bf16_t*)(p->ws + WS_WQB) + (size_t)i * 768 * 384, 768, 384, 768, 2)
    for (int i = 0; i < 2; ++i) TD_TRY(p->in[I_WKVB] + (size_t)i * 256 * 1024, (bf16_t*)(p->ws + WS_WK) + (size_t)i * 512 * 256, 1024, 256, 512, 3)
    for (int i = 0; i < 2; ++i) TD_TRY(p->in[I_WKVB] + (size_t)i * 256 * 1024, (bf16_t*)(p->ws + WS_WV) + (size_t)i * 512 * 256, 1024, 256, 512, 4)
    for (int i = 0; i < 8; ++i) TD_TRY(p->in[I_WPOOL] + (size_t)i * 256 * 256, (bf16_t*)(p->ws + WS_WPOOL) + (size_t)i * 256 * 256, 256, 256, 256, 0)
#undef TD_TRY
    return false;
}
constexpr int N_TITEMS = 2 * 896 + 2 * 144 + 2 * 64 + 2 * 64 + 2 * 512 + 8 * 32 + 4 * 2048 + 4 * 2048;
constexpr int N_MODU = 4 * 48;

DI void prologue_phase(int tid_o, int bid_o, KP p, LAS unsigned char* lds) {
    const int tid = tid_o, wid = tid >> 6, lane = tid & 63;
    LAS float* lf = (LAS float*)lds;
    for (int u = bid_o; u < N_MODU; u += gridDim.x) {
        const int l = u / 48, cb = u % 48;
        LAS float* sl = lf;
        LAS float* red = lf + 5120;
        for (int idx = tid; idx < 5120; idx += 512) { const int r = idx >> 10, k = idx & 1023; const float c = r < 4 ? p->in[I_C][r * 1024 + k] : p->in[I_CCTX][k]; sl[idx] = c / (1.f + __expf(-c)); }
        __syncthreads();
        float a[5][2];
#pragma unroll
        for (int r = 0; r < 5; ++r) { a[r][0] = 0.f; a[r][1] = 0.f; }
        const float* wp = p->in[I_WMOD] + ((size_t)l * 1024 + wid * 128) * MODW + cb * 128 + lane * 2;
#pragma unroll 16
        for (int kk = 0; kk < 128; ++kk) {
            const f32x2 wv = __builtin_nontemporal_load((const f32x2*)(wp + (size_t)kk * MODW));
#pragma unroll
            for (int r = 0; r < 5; ++r) { const float s = sl[r * 1024 + wid * 128 + kk]; a[r][0] += s * wv.x; a[r][1] += s * wv.y; }
        }
#pragma unroll
        for (int r = 0; r < 5; ++r) { red[(wid * 5 + r) * 128 + lane * 2] = a[r][0]; red[(wid * 5 + r) * 128 + lane * 2 + 1] = a[r][1]; }
        __syncthreads();
        for (int idx = tid; idx < 640; idx += 512) {
            const int r = idx >> 7, c = idx & 127; float s = p->in[I_BMOD][l * MODW + cb * 128 + c];
#pragma unroll
            for (int w = 0; w < 8; ++w) s += red[(w * 5 + r) * 128 + c];
            ((float*)(p->ws + WS_MOD))[(size_t)(l * 5 + r) * MODW + cb * 128 + c] = s;
        }
        __syncthreads();
    }
    for (int idx = bid_o * 512 + tid; idx < 32768; idx += gridDim.x * 512) {
        const int e0 = idx * 8;
        const f32x4 a = *(const f32x4*)(p->in[I_WSP] + e0), b = *(const f32x4*)(p->in[I_WSP] + e0 + 4);
        u32x4 w; w.x = pk_bf16(a[0], a[1]); w.y = pk_bf16(a[2], a[3]); w.z = pk_bf16(b[0], b[1]); w.w = pk_bf16(b[2], b[3]);
        *(u32x4*)((bf16_t*)(p->ws + WS_WSP) + e0) = w;
    }
    LAS float* sc = (LAS float*)(lds + 40960 + wid * 8448);
    const int G = gridDim.x;
    const bool lowb = bid_o < N_MODU && G > N_MODU;
    const int pool0 = G > N_MODU ? (N_TITEMS / 32) * 21 : N_TITEMS;
    const int it_begin = lowb ? bid_o * 8 + wid : (G > N_MODU ? pool0 + (bid_o - N_MODU) * 8 + wid : bid_o * 8 + wid);
    const int it_end = lowb ? pool0 : N_TITEMS;
    const int it_step = lowb ? N_MODU * 8 : (G > N_MODU ? (G - N_MODU) * 8 : G * 8);
    for (int it = it_begin; it < it_end; it += it_step) {
        TDesc d; int local;
        if (!tdesc_find(p, it, d, local)) continue;
        const int tiles_n = d.N / 32, tn = local % tiles_n, tk = local / tiles_n, n0 = tn * 32, k0 = tk * 64;
        { const int c = lane & 31, kh = lane >> 5; const int scol = tperm(d.perm, n0 + c);
            const float* sp = d.src + (size_t)(k0 + kh * 32) * d.ld + (scol >= 0 ? scol : 0);
            float v[32];
#pragma unroll
            for (int j = 0; j < 32; ++j) v[j] = scol >= 0 ? __builtin_nontemporal_load(sp + (size_t)j * d.ld) : 0.f;
#pragma unroll
            for (int j = 0; j < 32; ++j) sc[(kh * 32 + j) * 33 + c] = v[j]; }
        { const int ch = lane & 7, n = lane >> 3;
#pragma unroll
            for (int j4 = 0; j4 < 4; ++j4) { const int nn = n + 8 * j4; const LAS float* q = sc + (8 * ch) * 33 + nn;
                u32x4 o; o.x = pk_bf16(q[0 * 33], q[1 * 33]); o.y = pk_bf16(q[2 * 33], q[3 * 33]); o.z = pk_bf16(q[4 * 33], q[5 * 33]); o.w = pk_bf16(q[6 * 33], q[7 * 33]);
                bf16_t* dp = d.tiled ? d.dst + ((size_t)((n0 + nn) >> 8) * (d.K / 64) + tk) * 16384 + (size_t)((n0 + nn) & 255) * 64 + 8 * ch : d.dst + (size_t)(n0 + nn) * d.K + k0 + 8 * ch;
                *(u32x4*)dp = o; } }
    }
}

typedef _Float16 h16x4 __attribute__((ext_vector_type(4)));
DI void norm_phase(int tid_o, int bid_o, KP p, int layer, int which, bool first, bool final_) {
    const int wid = tid_o >> 6, lane = tid_o & 63;
    const float* gw = final_ ? p->in[I_FG] : (which == 0 ? p->in[I_N1G] : p->in[I_N2G]) + layer * D;
    bf16_t* H = (bf16_t*)(p->ws + WS_DELTA);
    _Float16* X16 = (_Float16*)(p->ws + WS_H);
    constexpr int NR = 4;
    for (int row0 = (bid_o * 8 + wid) * NR; row0 < T; row0 += gridDim.x * 8 * NR) {
        f32x4 v[NR][4];
        if (first) {
#pragma unroll
            for (int r = 0; r < NR; ++r) {
                const int row = row0 + r;
                const float* xr = row < T_CTX ? p->in[I_XP] + (size_t)row * D : p->in[I_XS] + (size_t)(row - T_CTX) * D;
#pragma unroll
                for (int j = 0; j < 4; ++j) v[r][j] = *(const f32x4*)(xr + j * 256 + lane * 4);
            }
        } else {
#pragma unroll
            for (int r = 0; r < NR; ++r)
#pragma unroll
                for (int j = 0; j < 4; ++j) v[r][j] = __builtin_convertvector(*(const h16x4*)(X16 + (size_t)(row0 + r) * D + j * 256 + lane * 4), f32x4);
        }
        float ss[NR];
#pragma unroll
        for (int r = 0; r < NR; ++r) {
            ss[r] = 0.f;
#pragma unroll
            for (int j = 0; j < 4; ++j) ss[r] += v[r][j][0] * v[r][j][0] + v[r][j][1] * v[r][j][1] + v[r][j][2] * v[r][j][2] + v[r][j][3] * v[r][j][3];
        }
#pragma unroll
        for (int o = 32; o; o >>= 1)
#pragma unroll
            for (int r = 0; r < NR; ++r) ss[r] += __shfl_xor(ss[r], o);
        float rs[NR];
#pragma unroll
        for (int r = 0; r < NR; ++r) rs[r] = rsqrtf(ss[r] * (1.f / D) + EPS);
        if (final_) {
#pragma unroll
            for (int j = 0; j < 4; ++j) {
                const int c = j * 256 + lane * 4; const f32x4 g4 = *(const f32x4*)(gw + c);
#pragma unroll
                for (int r = 0; r < NR; ++r) *(f32x4*)(p->out + (size_t)(row0 + r) * D + c) = v[r][j] * rs[r] * g4;
            }
        } else {
            if (first) {
#pragma unroll
                for (int r = 0; r < NR; ++r)
#pragma unroll
                    for (int j = 0; j < 4; ++j) *(h16x4*)(X16 + (size_t)(row0 + r) * D + j * 256 + lane * 4) = __builtin_convertvector(v[r][j], h16x4);
            }
            const float* md = (const float*)(p->ws + WS_MOD) + (size_t)(layer * 5 + cond_of_row(row0)) * MODW + (which ? 3 * D : 0);
#pragma unroll
            for (int j = 0; j < 4; ++j) {
                const int c = j * 256 + lane * 4;
                const f32x4 g4 = *(const f32x4*)(gw + c), sh = *(const f32x4*)(md + c), sc = *(const f32x4*)(md + D + c);
                const f32x4 gm = g4 * (sc + 1.f);
#pragma unroll
                for (int r = 0; r < NR; ++r) {
                    const f32x4 y = v[r][j] * rs[r] * gm + sh;
                    u32x2 w; w.x = pk_bf16(y[0], y[1]); w.y = pk_bf16(y[2], y[3]);
                    *(u32x2*)(H + (size_t)(row0 + r) * D + c) = w;
                }
            }
        }
    }
}

DI void rowop_phase(int tid_o, int bid_o, KP p, int i) {
    const int wid = tid_o >> 6, lane = tid_o & 63;
    const bf16_t* Z = (const bf16_t*)(p->ws + WS_Z);
    bf16_t* QN = (bf16_t*)(p->ws + WS_QN); bf16_t* CKV = (bf16_t*)(p->ws + WS_CKV); bf16_t* KPE = (bf16_t*)(p->ws + WS_KPE); bf16_t* VN = (bf16_t*)(p->ws + WS_VN);
    const float* qag = p->in[I_QAG] + i * 384; const float* kvg = p->in[I_KVAG] + i * 256; const float* vg = p->in[I_VG] + i * 512;
    constexpr int NR = 4;
    for (int it0 = (bid_o * 8 + wid) * NR; it0 < T; it0 += gridDim.x * 8 * NR) {
        u32x2 zz[NR][5];
#pragma unroll
        for (int r = 0; r < NR; ++r) {
            const bf16_t* zr = Z + (size_t)(it0 + r) * NZ;
            zz[r][0] = *(const u32x2*)(zr + 4 * lane); zz[r][1] = *(const u32x2*)(zr + 4 * (64 + lane)); zz[r][2] = *(const u32x2*)(zr + 4 * (128 + (lane < 40 ? lane : 0)));
            zz[r][3] = *(const u32x2*)(zr + 4 * (320 + lane)); zz[r][4] = *(const u32x2*)(zr + 4 * (384 + lane));
        }
#pragma unroll
        for (int r = 0; r < NR; ++r) {
            const int row = it0 + r;
            const u32x2 z0 = zz[r][0], z1 = zz[r][1], z2 = zz[r][2], z5 = zz[r][3], z6 = zz[r][4];
            float a0[4] = {bf_lo(z0.x), bf_hi(z0.x), bf_lo(z0.y), bf_hi(z0.y)};
            float a1[4] = {bf_lo(z1.x), bf_hi(z1.x), bf_lo(z1.y), bf_hi(z1.y)};
            float a2[4] = {bf_lo(z2.x), bf_hi(z2.x), bf_lo(z2.y), bf_hi(z2.y)};
            float a5[4] = {bf_lo(z5.x), bf_hi(z5.x), bf_lo(z5.y), bf_hi(z5.y)};
            float a6[4] = {bf_lo(z6.x), bf_hi(z6.x), bf_lo(z6.y), bf_hi(z6.y)};
            const float s0 = a0[0] * a0[0] + a0[1] * a0[1] + a0[2] * a0[2] + a0[3] * a0[3];
            const float s1 = a1[0] * a1[0] + a1[1] * a1[1] + a1[2] * a1[2] + a1[3] * a1[3];
            const float s2 = a2[0] * a2[0] + a2[1] * a2[1] + a2[2] * a2[2] + a2[3] * a2[3];
            const float s5 = a5[0] * a5[0] + a5[1] * a5[1] + a5[2] * a5[2] + a5[3] * a5[3] + a6[0] * a6[0] + a6[1] * a6[1] + a6[2] * a6[2] + a6[3] * a6[3];
            const float ssq = wave_sum(s0 + (lane < 32 ? s1 : 0.f));
            const float sskv = wave_sum((lane >= 32 ? s1 : 0.f) + (lane < 32 ? s2 : 0.f));
            const float ssv = wave_sum(s5);
            const float rq = rsqrtf(ssq * (1.f / 384.f) + EPS), rkv = rsqrtf(sskv * (1.f / 256.f) + EPS), rv = rsqrtf(ssv * (1.f / 512.f) + EPS);
            int krow, l, L; size_t kfbase; bool lat = row >= T_CTX; int b, tt;
            if (!lat) { b = row >> 8; tt = row & 255; krow = row; l = tt; L = 256; kfbase = (size_t)b * 8 * 256 * 96; }
            else { const int r2 = row - T_CTX; b = r2 >> 12; tt = r2 & 4095; krow = T_CTX + b * LLAT + 512 + tt; l = 512 + tt; L = LLAT; kfbase = KF_CTX + (size_t)b * 8 * LLAT * 96; }
            { const int c = 4 * lane; const f32x4 g = *(const f32x4*)(qag + c); u32x2 w; w.x = pk_bf16(a0[0] * rq * g[0], a0[1] * rq * g[1]); w.y = pk_bf16(a0[2] * rq * g[2], a0[3] * rq * g[3]); *(u32x2*)(QN + (size_t)row * 384 + c) = w; }
            if (lane < 32) { const int c = 256 + 4 * lane; const f32x4 g = *(const f32x4*)(qag + c); u32x2 w; w.x = pk_bf16(a1[0] * rq * g[0], a1[1] * rq * g[1]); w.y = pk_bf16(a1[2] * rq * g[2], a1[3] * rq * g[3]); *(u32x2*)(QN + (size_t)row * 384 + c) = w; }
            {
                const bool hi = lane >= 32; const int c = hi ? 4 * (lane - 32) : 128 + 4 * lane;
                const f32x4 g = *(const f32x4*)(kvg + c);
                f32x4 y;
#pragma unroll
                for (int e = 0; e < 4; ++e) y[e] = (hi ? a1[e] : a2[e]) * rkv * g[e];
                u32x2 w; w.x = pk_bf16(y[0], y[1]); w.y = pk_bf16(y[2], y[3]);
                *(u32x2*)(CKV + (size_t)krow * 256 + c) = w;
                if (!lat) *(f32x4*)(p->out + OUT_CKV + ((size_t)(b * 2 + i) * 256 + tt) * 256 + c) = y;
            }
            {
                const int j0 = ((lane - 32) & 7) * 4;
                float o[4], pr[4], op[4];
#pragma unroll
                for (int e = 0; e < 4; ++e) pr[e] = __shfl_xor(a2[e], 2);
                const int ax = j0 >> 4, pbit = (j0 >> 3) & 1, f0 = j0 & 7;
                if (lat) {
                    const float pos = (float)(ax == 0 ? (tt >> 6) : (tt & 63));
#pragma unroll
                    for (int e = 0; e < 4; ++e) { float s, cs; sincos_rr(pos * rope_inv(f0 + e), s, cs); o[e] = pbit ? (a2[e] * cs + pr[e] * s) : (a2[e] * cs - pr[e] * s); }
                } else {
#pragma unroll
                    for (int e = 0; e < 4; ++e) o[e] = a2[e];
                }
#pragma unroll
                for (int e = 0; e < 4; ++e) op[e] = __shfl_xor(o[e], 2);
                if (lane >= 32 && lane < 40) {
                    if (!lat) *(f32x4*)(p->out + OUT_KPE + ((size_t)(b * 2 + i) * 256 + tt) * 32 + j0) = (f32x4){a2[0], a2[1], a2[2], a2[3]};
                    u32x2 w;
                    if (pbit == 0) { w.x = pk_bf16(o[0], op[0]); w.y = pk_bf16(o[1], op[1]); }
                    else { w.x = pk_bf16(op[2], o[2]); w.y = pk_bf16(op[3], o[3]); }
                    *(u32x2*)(KPE + (size_t)krow * 32 + ax * 16 + 2 * (f0 + 2 * pbit)) = w;
                }
            }
            { const int c = 4 * lane; const f32x4 g = *(const f32x4*)(vg + c); u32x2 w; w.x = pk_bf16(a5[0] * rv * g[0], a5[1] * rv * g[1]); w.y = pk_bf16(a5[2] * rv * g[2], a5[3] * rv * g[3]); *(u32x2*)(VN + (size_t)row * 512 + c) = w; }
            { const int c = 256 + 4 * lane; const f32x4 g = *(const f32x4*)(vg + c); u32x2 w; w.x = pk_bf16(a6[0] * rv * g[0], a6[1] * rv * g[1]); w.y = pk_bf16(a6[2] * rv * g[2], a6[3] * rv * g[3]); *(u32x2*)(VN + (size_t)row * 512 + c) = w; }
        }
    }
    for (int it = bid_o * 8 + wid; it < 2048; it += gridDim.x * 8) {
        {
            const int r = it, b = r >> 9, pp = r & 511;
            const float* src = p->in[I_CCKV] + ((size_t)(b * 2 + i) * 512 + pp) * 256;
            const f32x4 v = *(const f32x4*)(src + 4 * lane);
            u32x2 w; w.x = pk_bf16(v[0], v[1]); w.y = pk_bf16(v[2], v[3]);
            *(u32x2*)(CKV + (size_t)(T_CTX + b * LLAT + pp) * 256 + 4 * lane) = w;
            {
                const f32x4 k = *(const f32x4*)(p->in[I_CKPE] + ((size_t)(b * 2 + i) * 512 + pp) * 32 + 4 * (lane & 7));
                const int j0 = 4 * (lane & 7), ax = j0 >> 4, pbit = (j0 >> 3) & 1, f0 = j0 & 7;
                float op[4];
#pragma unroll
                for (int e = 0; e < 4; ++e) op[e] = __shfl_xor(k[e], 2);
                if (lane < 8) {
                    u32x2 w;
                    if (pbit == 0) { w.x = pk_bf16(k[0], op[0]); w.y = pk_bf16(k[1], op[1]); }
                    else { w.x = pk_bf16(op[2], k[2]); w.y = pk_bf16(op[3], k[3]); }
                    *(u32x2*)(KPE + (size_t)(T_CTX + b * LLAT + pp) * 32 + ax * 16 + 2 * (f0 + 2 * pbit)) = w;
                }
            }
        }
    }
}

constexpr int AK_ROW = 208, AV_ROW = 136, AK_BUF = 64 * AK_ROW, AV_BUF = 64 * AV_ROW, AV_OFF = 2 * AK_BUF;
#define MFMA32(a, b, c) __builtin_amdgcn_mfma_f32_32x32x16_bf16((a), (b), (c), 0, 0, 0)
DI void attn_unit(int tid_o, LAS unsigned char* lds, const bf16_t* Qb, const bf16_t* Kb, const bf16_t* Vb, int L, bf16_t* Ob) {
    const int tid = tid_o, wid = tid >> 6, lane = tid & 63, r32 = lane & 31, hh = lane >> 5;
    bf16x8 qf[6];
    { const bf16_t* qp = Qb + (size_t)(wid * 32 + r32) * 768 + hh * 8;
#pragma unroll
        for (int s = 0; s < 6; ++s) qf[s] = *(const bf16x8*)(qp + s * 16); }
    const bool lo256 = tid < 256;
    const int c1 = tid + 512;
    const bf16_t* g0 = Kb; const unsigned go0 = (tid / 12) * 96 + (tid % 12) * 8;
    const unsigned l0 = (tid / 12) * AK_ROW + (tid % 12) * 16;
    const bf16_t* g1 = lo256 ? Kb : Vb; const unsigned go1 = lo256 ? (c1 / 12) * 96 + (c1 % 12) * 8 : (unsigned)((tid - 256) >> 3) * L + ((tid - 256) & 7) * 8;
    const unsigned l1 = lo256 ? (c1 / 12) * AK_ROW + (c1 % 12) * 16 : AV_OFF + ((tid - 256) >> 3) * AV_ROW + ((tid - 256) & 7) * 16;
    const bf16_t* g2 = Vb; const unsigned go2 = (unsigned)((tid + 256) >> 3) * L + ((tid + 256) & 7) * 8;
    const unsigned l2 = AV_OFF + ((tid + 256) >> 3) * AV_ROW + ((tid + 256) & 7) * 16;
    const int st1 = lo256 ? 64 * 96 : 64;
    const int nt = L / 64;
    u32x4 s0r, s1r, s2r;
    s0r = *(const u32x4*)(g0 + go0); s1r = *(const u32x4*)(g1 + go1); if (lo256) s2r = *(const u32x4*)(g2 + go2);
    {
        *(LAS u32x4*)(lds + l0) = s0r;
        if (lo256) { *(LAS u32x4*)(lds + l1) = s1r; *(LAS u32x2*)(lds + l2) = (u32x2){s2r.x, s2r.y}; *(LAS u32x2*)(lds + l2 + 8) = (u32x2){s2r.z, s2r.w}; }
        else { *(LAS u32x2*)(lds + l1) = (u32x2){s1r.x, s1r.y}; *(LAS u32x2*)(lds + l1 + 8) = (u32x2){s1r.z, s1r.w}; }
    }
    __syncthreads();
    f32x16 o0, o1;
#pragma unroll
    for (int e = 0; e < 16; ++e) { o0[e] = 0.f; o1[e] = 0.f; }
    float mrun = -INFINITY, lsum = 0.f;
    for (int kt = 0; kt < nt; ++kt) {
        const int buf = kt & 1;
        const bool pre = kt + 1 < nt;
        if (pre) {
            s0r = *(const u32x4*)(g0 + (go0 + (unsigned)(kt + 1) * 64 * 96)); s1r = *(const u32x4*)(g1 + (go1 + (unsigned)(kt + 1) * st1)); if (lo256) s2r = *(const u32x4*)(g2 + (go2 + (unsigned)(kt + 1) * 64));
        }
        f32x16 sa, sb;
#pragma unroll
        for (int e = 0; e < 16; ++e) { sa[e] = 0.f; sb[e] = 0.f; }
        const LAS unsigned char* kb = lds + buf * AK_BUF + r32 * AK_ROW + hh * 16;
        __builtin_amdgcn_s_setprio(1);
#pragma unroll
        for (int s = 0; s < 6; ++s) {
            const bf16x8 a0 = *(const LAS bf16x8*)(kb + s * 32), a1 = *(const LAS bf16x8*)(kb + 32 * AK_ROW + s * 32);
            sa = MFMA32(a0, qf[s], sa); sb = MFMA32(a1, qf[s], sb);
        }
        __builtin_amdgcn_s_setprio(0);
        __builtin_amdgcn_sched_barrier(0);
        float mx = sa[0];
#pragma unroll
        for (int e = 1; e < 16; ++e) mx = fmaxf(mx, sa[e]);
#pragma unroll
        for (int e = 0; e < 16; ++e) mx = fmaxf(mx, sb[e]);
        mx = fmaxf(mx, __shfl_xor(mx, 32));
        const float mn = fmaxf(mrun, mx);
        const float alpha = __builtin_amdgcn_exp2f(mrun - mn);
        mrun = mn;
        float ps = 0.f;
#pragma unroll
        for (int e = 0; e < 16; ++e) { sa[e] = __builtin_amdgcn_exp2f(sa[e] - mn); ps += sa[e]; }
#pragma unroll
        for (int e = 0; e < 16; ++e) { sb[e] = __builtin_amdgcn_exp2f(sb[e] - mn); ps += sb[e]; }
        lsum = lsum * alpha + ps;
        o0 = o0 * alpha; o1 = o1 * alpha;
        __builtin_amdgcn_sched_barrier(0);
        const LAS unsigned char* vb = lds + AV_OFF + buf * AV_BUF + r32 * AV_ROW + hh * 8;
#pragma unroll
        for (int kb2 = 0; kb2 < 2; ++kb2)
#pragma unroll
            for (int s = 0; s < 2; ++s) {
                u32x4 pw;
                if (kb2 == 0) { pw.x = pk_bf16(sa[8 * s + 0], sa[8 * s + 1]); pw.y = pk_bf16(sa[8 * s + 2], sa[8 * s + 3]); pw.z = pk_bf16(sa[8 * s + 4], sa[8 * s + 5]); pw.w = pk_bf16(sa[8 * s + 6], sa[8 * s + 7]); }
                else { pw.x = pk_bf16(sb[8 * s + 0], sb[8 * s + 1]); pw.y = pk_bf16(sb[8 * s + 2], sb[8 * s + 3]); pw.z = pk_bf16(sb[8 * s + 4], sb[8 * s + 5]); pw.w = pk_bf16(sb[8 * s + 6], sb[8 * s + 7]); }
                const bf16x8 pb = __builtin_bit_cast(bf16x8, pw);
                const int ko = (kb2 * 32 + 16 * s) * 2;
                const u32x2 v0l = *(const LAS u32x2*)(vb + ko), v0h = *(const LAS u32x2*)(vb + ko + 16);
                const u32x2 v1l = *(const LAS u32x2*)(vb + 32 * AV_ROW + ko), v1h = *(const LAS u32x2*)(vb + 32 * AV_ROW + ko + 16);
                const bf16x8 va0 = __builtin_bit_cast(bf16x8, (u32x4){v0l.x, v0l.y, v0h.x, v0h.y});
                const bf16x8 va1 = __builtin_bit_cast(bf16x8, (u32x4){v1l.x, v1l.y, v1h.x, v1h.y});
                o0 = MFMA32(va0, pb, o0); o1 = MFMA32(va1, pb, o1);
            }
        if (pre) {
            const unsigned bo = (buf ^ 1) * AK_BUF, vo = (buf ^ 1) * AV_BUF;
            *(LAS u32x4*)(lds + bo + l0) = s0r;
            if (lo256) { *(LAS u32x4*)(lds + bo + l1) = s1r; *(LAS u32x2*)(lds + vo + l2) = (u32x2){s2r.x, s2r.y}; *(LAS u32x2*)(lds + vo + l2 + 8) = (u32x2){s2r.z, s2r.w}; }
            else { *(LAS u32x2*)(lds + vo + l1) = (u32x2){s1r.x, s1r.y}; *(LAS u32x2*)(lds + vo + l1 + 8) = (u32x2){s1r.z, s1r.w}; }
        }
        __syncthreads();
    }
    const float lt = lsum + __shfl_xor(lsum, 32);
    const float inv = 1.f / lt;
    bf16_t* op = Ob + (size_t)(wid * 32 + r32) * D + 4 * hh;
#pragma unroll
    for (int g = 0; g < 4; ++g) {
        u32x2 w0; w0.x = pk_bf16(o0[4 * g] * inv, o0[4 * g + 1] * inv); w0.y = pk_bf16(o0[4 * g + 2] * inv, o0[4 * g + 3] * inv);
        u32x2 w1; w1.x = pk_bf16(o1[4 * g] * inv, o1[4 * g + 1] * inv); w1.y = pk_bf16(o1[4 * g + 2] * inv, o1[4 * g + 3] * inv);
        *(u32x2*)(op + 8 * g) = w0; *(u32x2*)(op + 32 + 8 * g) = w1;
    }
}
DI void attn_phase(int tid_o, int bid_o, KP p, LAS unsigned char* lds) {
    const bf16_t* Q = (const bf16_t*)(p->ws + WS_Q); const bf16_t* KF = (const bf16_t*)(p->ws + WS_KF); const bf16_t* VT = (const bf16_t*)(p->ws + WS_VT);
    bf16_t* MIX = (bf16_t*)((unsigned char*)p->out);
    for (int u = bid_o; u < 768; u += gridDim.x) {
        if (u < 512) {
            const int x = u & 7, r = u >> 3, bh = x * 4 + (r >> 4), qb = r & 15, b = bh >> 3, h = bh & 7;
            const int tok0 = T_CTX + b * 4096 + qb * 256;
            attn_unit(tid_o, lds, Q + (size_t)tok0 * 768 + h * 96, KF + KF_CTX + (size_t)(b * 8 + h) * LLAT * 96, VT + VT_CTX + (size_t)(b * 8 + h) * 64 * LLAT, LLAT, MIX + (size_t)tok0 * D + h * 64);
        } else {
            const int bh = u - 512, b = bh >> 3, h = bh & 7;
            const int tok0 = b * 256;
            attn_unit(tid_o, lds, Q + (size_t)tok0 * 768 + h * 96, KF + (size_t)(b * 8 + h) * 256 * 96, VT + (size_t)(b * 8 + h) * 64 * 256, 256, MIX + (size_t)tok0 * D + h * 64);
        }
    }
}

DI void spatial_phase(int tid_o, int bid_o, KP p, LAS unsigned char* lds, int i) {
    const int tid = tid_o, wid = tid >> 6, lane = tid & 63, fr = lane & 15, fq = lane >> 4;
    const bf16_t* VN = (const bf16_t*)(p->ws + WS_VN); const bf16_t* Z = (const bf16_t*)(p->ws + WS_Z); const bf16_t* WSP = (const bf16_t*)(p->ws + WS_WSP) + (size_t)i * 8 * 128 * 128;
    bf16_t* MIX = (bf16_t*)((unsigned char*)p->out);
    const float* bs = p->in[I_BSP] + i * 8 * 128;
    const int NU = (T / 128) * 8;
    u32x4 vv[2];
    if (bid_o < NU) {
        const int chunk = bid_o >> 3, g = bid_o & 7, tok0 = chunk * 128;
#pragma unroll
        for (int k = 0; k < 2; ++k) { const int id = tid + 512 * k, q = id >> 3, c0 = (id & 7) * 8; vv[k] = *(const u32x4*)(VN + (size_t)(tok0 + q) * 512 + g * 64 + c0); }
    }
    const bool ginv = (gridDim.x & 7) == 0;
    bf16x8 wa[4]; float bias = 0.f;
    if (ginv && bid_o < NU) {
        const int g = bid_o & 7;
#pragma unroll
        for (int k = 0; k < 4; ++k) wa[k] = *(const bf16x8*)(WSP + ((size_t)g * 128 + 16 * wid + fr) * 128 + 32 * k + fq * 8);
        bias = bs[g * 128 + 16 * wid + fr];
    }
    for (int u = bid_o; u < NU; u += gridDim.x) {
        const int chunk = u >> 3, g = u & 7, tok0 = chunk * 128;
        const int prow = 16 * wid + fr, tok = tok0 + prow;
        u32x2 uu[4];
#pragma unroll
        for (int n = 0; n < 4; ++n) uu[n] = *(const u32x2*)(Z + (size_t)tok * NZ + 768 + g * 64 + 16 * n + 4 * fq);
#pragma unroll
        for (int k = 0; k < 2; ++k) {
            const int id = tid + 512 * k, q = id >> 3, c0 = (id & 7) * 8;
            const u32x4 v = vv[k];
            LAS bf16_t* dst = (LAS bf16_t*)(lds + c0 * 272 + q * 2);
            dst[0 * 136] = (bf16_t)(v.x & 0xffff); dst[1 * 136] = (bf16_t)(v.x >> 16); dst[2 * 136] = (bf16_t)(v.y & 0xffff); dst[3 * 136] = (bf16_t)(v.y >> 16);
            dst[4 * 136] = (bf16_t)(v.z & 0xffff); dst[5 * 136] = (bf16_t)(v.z >> 16); dst[6 * 136] = (bf16_t)(v.w & 0xffff); dst[7 * 136] = (bf16_t)(v.w >> 16);
        }
        __syncthreads();
        { const int un = u + gridDim.x;
          if (un < NU) { const int chn = un >> 3, gn = un & 7, tk0 = chn * 128;
#pragma unroll
            for (int k = 0; k < 2; ++k) { const int id = tid + 512 * k, q = id >> 3, c0 = (id & 7) * 8; vv[k] = *(const u32x4*)(VN + (size_t)(tk0 + q) * 512 + gn * 64 + c0); } } }
        if (!ginv) {
#pragma unroll
            for (int k = 0; k < 4; ++k) wa[k] = *(const bf16x8*)(WSP + ((size_t)g * 128 + 16 * wid + fr) * 128 + 32 * k + fq * 8);
            bias = bs[g * 128 + prow];
        }
        f32x4 acc[4];
#pragma unroll
        for (int n = 0; n < 4; ++n) acc[n] = (f32x4){0.f, 0.f, 0.f, 0.f};
#pragma unroll
        for (int k = 0; k < 4; ++k) {
#pragma unroll
            for (int n = 0; n < 4; ++n) {
                const bf16x8 b = *(const LAS bf16x8*)(lds + (16 * n + fr) * 272 + (32 * k + fq * 8) * 2);
                acc[n] = __builtin_amdgcn_mfma_f32_16x16x32_bf16(b, wa[k], acc[n], 0, 0, 0);
            }
        }
#pragma unroll
        for (int n = 0; n < 4; ++n) {
            const int ch = g * 64 + 16 * n + 4 * fq;
            u32x2 w; w.x = pk_bf16(bf_lo(uu[n].x) * (acc[n][0] + bias), bf_hi(uu[n].x) * (acc[n][1] + bias)); w.y = pk_bf16(bf_lo(uu[n].y) * (acc[n][2] + bias), bf_hi(uu[n].y) * (acc[n][3] + bias));
            *(u32x2*)(MIX + (size_t)tok * D + 512 + ch) = w;
        }
        __syncthreads();
    }
}

template <int HW>
DI void pd_item(const bf16_t* hb, bf16_t* pb, int tt0, int len) {
    constexpr int NRW = 8 + 2 * HW;
    u32x4 rw[NRW];
#pragma unroll
    for (int k = 0; k < NRW; ++k) {
        const int t2 = tt0 - HW + k;
        rw[k] = (t2 >= 0 && t2 < len) ? *(const u32x4*)(hb + (size_t)t2 * D) : (u32x4){0u, 0u, 0u, 0u};
    }
    float sum[8];
#pragma unroll
    for (int e = 0; e < 8; ++e) sum[e] = 0.f;
#pragma unroll
    for (int k = 0; k < 2 * HW; ++k) {
        sum[0] += bf_lo(rw[k].x); sum[1] += bf_hi(rw[k].x); sum[2] += bf_lo(rw[k].y); sum[3] += bf_hi(rw[k].y); sum[4] += bf_lo(rw[k].z); sum[5] += bf_hi(rw[k].z); sum[6] += bf_lo(rw[k].w); sum[7] += bf_hi(rw[k].w);
    }
#pragma unroll
    for (int j = 0; j < 8; ++j) {
        const int tt = tt0 + j, lo = max(tt - HW, 0), hi = min(tt + HW, len);
        const float ic = 1.f / (float)(hi - lo);
        const u32x4 v = rw[j + HW];
        u32x4 w;
        w.x = pk_bf16(sum[0] * ic - bf_lo(v.x), sum[1] * ic - bf_hi(v.x)); w.y = pk_bf16(sum[2] * ic - bf_lo(v.y), sum[3] * ic - bf_hi(v.y));
        w.z = pk_bf16(sum[4] * ic - bf_lo(v.z), sum[5] * ic - bf_hi(v.z)); w.w = pk_bf16(sum[6] * ic - bf_lo(v.w), sum[7] * ic - bf_hi(v.w));
        *(u32x4*)(pb + (size_t)tt * D) = w;
        if (j < 7) {
            const u32x4 a = rw[j + 2 * HW], s2 = rw[j];
            sum[0] += bf_lo(a.x) - bf_lo(s2.x); sum[1] += bf_hi(a.x) - bf_hi(s2.x); sum[2] += bf_lo(a.y) - bf_lo(s2.y); sum[3] += bf_hi(a.y) - bf_hi(s2.y);
            sum[4] += bf_lo(a.z) - bf_lo(s2.z); sum[5] += bf_hi(a.z) - bf_hi(s2.z); sum[6] += bf_lo(a.w) - bf_lo(s2.w); sum[7] += bf_hi(a.w) - bf_hi(s2.w);
        }
    }
}
DI void pooldiff_phase(int tid_o, int bid_o, KP p) {
    const bf16_t* H = (const bf16_t*)(p->ws + WS_DELTA); bf16_t* PD = (bf16_t*)(p->ws + WS_PD);
    const int wid = tid_o >> 6, lane = tid_o & 63;
    for (int wi = bid_o * 8 + wid; wi < (T / 16) * 4; wi += gridDim.x * 8) {
        const int gi = wi & 3, tb = (wi >> 2) * 2 + (lane >> 5), c0 = gi * 256 + (lane & 31) * 8;
        const int tok0 = tb * 8;
        int s0, len;
        if (tok0 < T_CTX) { s0 = tok0 & ~255; len = 256; } else { s0 = T_CTX + ((tok0 - T_CTX) & ~4095); len = 4096; }
        const int tt0 = tok0 - s0;
        const bf16_t* hb = H + (size_t)s0 * D + c0; bf16_t* pb = PD + (size_t)s0 * D + c0;
        if (gi == 0) pd_item<1>(hb, pb, tt0, len);
        else if (gi == 1) pd_item<2>(hb, pb, tt0, len);
        else if (gi == 2) pd_item<4>(hb, pb, tt0, len);
        else pd_item<8>(hb, pb, tt0, len);
    }
}

DI void run_phase(int tid_o, int bid_o, KP p, LAS unsigned char* lds, int ph) {
    const float* MOD = (const float*)(p->ws + WS_MOD);

#ifndef DIS_PRO
    if (ph == 0) { prologue_phase(tid_o, bid_o, p, lds); return; }
#endif


#ifndef DIS_NORMF
    if (ph == 31) { norm_phase(tid_o, bid_o, p, 0, 0, false, true); return; }
#endif

    const int q = ph - 1, pair = q / 15, r = q % 15;
    const bool ab = r < 9;
    const int layer = pair * 2 + (ab ? 0 : 1), s = ab ? r : r - 9, i = pair;
    const int slot_n2 = ab ? 6 : 3;

#ifndef DIS_NORM
    if (s == 0) { norm_phase(tid_o, bid_o, p, layer, 0, layer == 0, false); return; }
    if (s == slot_n2) { norm_phase(tid_o, bid_o, p, layer, 1, false, false); return; }
#endif

    if (s == slot_n2 + 1) {
        pg8::Gemm g{(const bf16_t*)(p->ws + WS_DELTA), (const bf16_t*)(p->ws + WS_WFF1) + (size_t)layer * FF * 1024, 1024, 1024, 1024, 0, T / 256, FF / 256, 0, nullptr, nullptr, 0, 0, 0};
        Epi<EM_FF1> E{(bf16_t*)(p->ws + WS_FFH), nullptr, nullptr, nullptr, nullptr, nullptr, nullptr};

#ifndef DIS_FF1
        pg8::gemm_phase(tid_o, bid_o, lds, g, E);
#endif
        return;
    }
    if (s == slot_n2 + 2) {

        pg8::Gemm g{(const bf16_t*)(p->ws + WS_FFH), (const bf16_t*)(p->ws + WS_WFF2) + (size_t)layer * 1024 * FF, FF, FF, FF, 0, T / 256, 4, 0, nullptr, nullptr, 1, 1, 1};
        Epi<EM_RES> E{(bf16_t*)(p->ws + WS_H), nullptr, nullptr, nullptr, MOD + (size_t)layer * 5 * MODW + 5 * D, nullptr, nullptr};
#ifndef DIS_FF2
        pg8::gemm_phase(tid_o, bid_o, lds, g, E); return;
#else
        return;
#endif
    }
    if (ab) {
        if (s == 1) {
            pg8::Gemm g{(const bf16_t*)(p->ws + WS_DELTA), (const bf16_t*)(p->ws + WS_WIN) + (size_t)i * NZ * 1024, 1024, 1024, 1024, 0, T / 256, NZ / 256, 0, nullptr, nullptr, 0, 0, 0};
            Epi<EM_Z> E{(bf16_t*)(p->ws + WS_Z), nullptr, nullptr, nullptr, nullptr, nullptr, nullptr};
#ifndef DIS_ZIN
            pg8::gemm_phase(tid_o, bid_o, lds, g, E); return;
#else
            return;
#endif
        }
#ifndef DIS_ROWOP
        if (s == 2) { rowop_phase(tid_o, bid_o, p, i); return; }
#else
        if (s == 2) return;
#endif
        if (s == 3) {
            { pg8::Gemm g{(const bf16_t*)(p->ws + WS_QN), (const bf16_t*)(p->ws + WS_WQB) + (size_t)i * 768 * 384, 384, 384, 384, 0, T / 256, 3, 0, nullptr, nullptr, 0, 0, 0};
              Epi<EM_Q> E{(bf16_t*)(p->ws + WS_Q), nullptr, nullptr, nullptr, nullptr, nullptr, nullptr};
#ifndef DIS_Q
              pg8::gemm_phase(tid_o, bid_o, lds, g, E); }
#else
              }
#endif
            { pg8::Gemm g{(const bf16_t*)(p->ws + WS_CKV), (const bf16_t*)(p->ws + WS_WK) + (size_t)i * 512 * 256, 256, 256, 256, 0, KR / 256, 2, 224, nullptr, nullptr, 0, 0, 0};
              Epi<EM_K> E{(bf16_t*)(p->ws + WS_KF), nullptr, nullptr, nullptr, nullptr, nullptr, (const bf16_t*)(p->ws + WS_KPE)};
#ifndef DIS_K
              pg8::gemm_phase(tid_o, bid_o, lds, g, E); }
#else
              }
#endif
            { pg8::Gemm g{(const bf16_t*)(p->ws + WS_WV) + (size_t)i * 512 * 256, (const bf16_t*)(p->ws + WS_CKV), 256, 256, 256, 0, 2, KR / 256, 208, nullptr, nullptr, 0, 0, 0};
              Epi<EM_VT> E{(bf16_t*)(p->ws + WS_VT), nullptr, nullptr, nullptr, nullptr, nullptr, nullptr};
#ifndef DIS_V
              pg8::gemm_phase(tid_o, bid_o, lds, g, E); }
#else
              }
#endif
#ifndef DIS_SPAT
            spatial_phase(tid_o, bid_o, p, lds, i);
#else

#endif
            return;
        }
#ifndef DIS_ATTN
        if (s == 4) { attn_phase(tid_o, bid_o, p, lds); return; }
#else
        if (s == 4) return;
#endif
        if (s == 5) {
            pg8::Gemm g{(const bf16_t*)((unsigned char*)p->out), (const bf16_t*)(p->ws + WS_WOUT) + (size_t)i * 1024 * 1024, 1024, 1024, 1024, 0, T / 256, 4, 0, nullptr, nullptr, 0, 0, 1};
            Epi<EM_RES> E{(bf16_t*)(p->ws + WS_H), nullptr, nullptr, nullptr, MOD + (size_t)layer * 5 * MODW + 2 * D, nullptr, nullptr};
#ifndef DIS_OUT
            pg8::gemm_phase(tid_o, bid_o, lds, g, E); return;
#else
            return;
#endif
        }
    } else {
#ifndef DIS_PD
        if (s == 1) { pooldiff_phase(tid_o, bid_o, p); return; }
#else
        if (s == 1) return;
#endif
        if (s == 2) {
            pg8::Gemm g{(const bf16_t*)(p->ws + WS_PD), (const bf16_t*)(p->ws + WS_WPOOL) + (size_t)i * 1024 * 256, 1024, 256, 256, 256, T / 256, 4, 0, nullptr, nullptr, 0, 0, 1};
            Epi<EM_RES> E{(bf16_t*)(p->ws + WS_H), nullptr, nullptr, nullptr, MOD + (size_t)layer * 5 * MODW + 2 * D, p->in[I_PSCALE] + i * D, nullptr};
#ifndef DIS_POOL
            pg8::gemm_phase(tid_o, bid_o, lds, g, E); return;
#else
            return;
#endif
        }
    }
}


#define XB_TMO      128
#define XB_XCNT(j)  (256  + 64 * (j))
#define XB_XSUB(j)  (1280 + 64 * (j))
#define XB_XGEN(j)  (2304 + 64 * (j))
#define XB_TOP      3328
#define XB_TOPGEN   3392
#define XCD_BAR_WORDS 3456
#define XB_SPIN_CAP (1u << 22)
DI unsigned xb_ld(unsigned* p)              { return __hip_atomic_load(p, __ATOMIC_RELAXED, __HIP_MEMORY_SCOPE_AGENT); }
DI unsigned xb_add(unsigned* p, unsigned v) { return __hip_atomic_fetch_add(p, v, __ATOMIC_RELAXED, __HIP_MEMORY_SCOPE_AGENT); }
DI unsigned xb_xcc_id() { return (unsigned)__builtin_amdgcn_s_getreg((3 << 11) | 20) & 0xFu; }
#define XB_SPIN(cond, bar) do { unsigned _sp = 0; while (cond) { __builtin_amdgcn_s_sleep(1); \
    if ((++_sp & 255u) == 0u) { if (xb_ld(&(bar)[XB_TMO])) break; if (_sp > XB_SPIN_CAP) { atomicAdd(&(bar)[XB_TMO], 1u); break; } } } } while (0)
DI void xcd_barrier_complete(unsigned* bar, unsigned x, unsigned& nloc, unsigned& nx) {
    const unsigned G = gridDim.x;
    unsigned sum, cnt, mine, sp = 0u;
    for (;;) {
        sum = 0u; cnt = 0u; mine = 0u;
#pragma unroll
        for (unsigned j = 0; j < 16; ++j) { const unsigned c = xb_ld(&bar[XB_XCNT(j)]); sum += c; cnt += (c > 0u) ? 1u : 0u; mine = (j == x) ? c : mine; }
        if (sum == G) break;
        __builtin_amdgcn_s_sleep(1);
        if ((++sp & 255u) == 0u) { if (xb_ld(&bar[XB_TMO])) break; if (sp > XB_SPIN_CAP) { atomicAdd(&bar[XB_TMO], 1u); break; } }
    }
    nloc = mine > 0u ? mine : 1u; nx = cnt > 0u ? cnt : 1u;
}
DI void xcd_barrier(unsigned* bar, unsigned x, volatile LAS unsigned* st, int tid) {
    asm volatile("s_waitcnt vmcnt(0)" ::: "memory");
    __syncthreads();
    if (tid == 0) {
        __builtin_amdgcn_s_waitcnt(0);
        unsigned nloc = st[0], nx = st[1];
        if (nloc == 0u) { xcd_barrier_complete(bar, x, nloc, nx); st[0] = nloc; st[1] = nx; }
        const unsigned old = xb_add(&bar[XB_XSUB(x)], 1u);
        const unsigned gen = old / nloc;
        if (old + 1u == (gen + 1u) * nloc) {
            __builtin_amdgcn_fence(__ATOMIC_RELEASE, "agent");
            asm volatile("s_waitcnt vmcnt(0)" ::: "memory");
            const unsigned og = xb_add(&bar[XB_TOP], 1u);
            const unsigned tg = og / nx;
            if (og + 1u == (tg + 1u) * nx) xb_add(&bar[XB_TOPGEN], 1u);
            else XB_SPIN(xb_ld(&bar[XB_TOPGEN]) == tg, bar);
            __builtin_amdgcn_fence(__ATOMIC_ACQUIRE, "agent");
            xb_add(&bar[XB_XGEN(x)], 1u);
            asm volatile("s_waitcnt vmcnt(0)" ::: "memory");
        } else {
            XB_SPIN(xb_ld(&bar[XB_XGEN(x)]) == gen, bar);
            __builtin_amdgcn_fence(__ATOMIC_ACQUIRE, "agent");
            asm volatile("s_waitcnt vmcnt(0)" ::: "memory");
        }
    }
    __syncthreads();
}

#ifndef REPMASK
#define REPMASK 0
#endif
DI int phase_class(int ph) {
    if (ph == 0) return 0;
    if (ph == 31) return 15;
    const int q = ph - 1, r = q % 15; const bool ab = r < 9; const int s = ab ? r : r - 9, n2 = ab ? 6 : 3;
    if (s == 0 || s == n2) return 1;
    if (s == n2 + 1) return 7;
    if (s == n2 + 2) return 15;
    if (ab) { if (s == 1) return 2; if (s == 2) return 3; if (s == 3) return 4; if (s == 4) return 5; if (s == 5) return ph == 6 ? 6 : 15; }
    else { if (s == 1) return 8; }
    return 15;
}
__global__ void __launch_bounds__(512, 2) fwd_megakernel(Params p) {
    extern __shared__ __attribute__((aligned(16))) unsigned char smem[];
    LAS unsigned char* lds = (LAS unsigned char*)smem;
    volatile LAS unsigned* xst = (volatile LAS unsigned*)(lds + XST_OFF);
    unsigned* bar = (unsigned*)(p.ws + WS_CTL);
    const unsigned xcc = xb_xcc_id();
    if (p.coop) {
        if (threadIdx.x == 0) { xst[0] = 0u; xst[1] = 0u; (void)xb_add(&bar[XB_XCNT(xcc)], 1u); }
        __syncthreads();
    }
    if (p.ph_lo < 0) cg::this_grid().sync();
    for (int ph = p.ph_lo; ph < p.ph_hi; ++ph) {
#if REPMASK
        const int reps = 1 + ((REPMASK >> phase_class(ph)) & 1);
#else
        const int reps = 1;
#endif
#pragma nounroll
        for (int rep = 0; rep < reps; ++rep) {
            int tid_o = (int)__builtin_amdgcn_workitem_id_x(), bid_o = (int)__builtin_amdgcn_workgroup_id_x();
            asm volatile("" : "+v"(tid_o)); asm volatile("" : "+s"(bid_o));
            KP kp = (KP)__builtin_amdgcn_kernarg_segment_ptr(); asm volatile("" : "+s"(kp));
            run_phase(tid_o, bid_o, kp, lds, ph);
            if (rep + 1 < reps || ph + 1 < p.ph_hi) xcd_barrier(bar, xcc, xst, tid_o);
        }
    }
}

extern "C" void kernel_launch(void* const* d_in, const int* in_sizes, int n_in, void* d_out, int out_size, void* d_ws, size_t ws_size, hipStream_t stream) {
    static int grid = 0;
    if (grid == 0) {
        if (n_in != 24 || ws_size < WS_TOTAL) { fprintf(stderr, "kernel_launch: unexpected n_in %d / ws_size %zu (need %zu)\n", n_in, ws_size, (size_t)WS_NEED); grid = -1; return; }
        int dev = 0, cus = 0, per_cu = 0;
        hipGetDevice(&dev);
        hipDeviceGetAttribute(&cus, hipDeviceAttributeMultiprocessorCount, dev);
        if (hipFuncSetAttribute((const void*)fwd_megakernel, hipFuncAttributeMaxDynamicSharedMemorySize, LDS_BYTES) != hipSuccess) { fprintf(stderr, "kernel_launch: hipFuncSetAttribute failed\n"); grid = -1; return; }
        if (hipOccupancyMaxActiveBlocksPerMultiprocessor(&per_cu, (const void*)fwd_megakernel, 512, LDS_BYTES) != hipSuccess || per_cu < 1) { fprintf(stderr, "kernel_launch: occupancy query gave %d\n", per_cu); per_cu = 1; (void)hipGetLastError(); }
        grid = cus * 1;
        if (grid <= 0) grid = 256;
    }
    if (grid < 0) return;
    Params p{};
    for (int i = 0; i < 24; ++i) p.in[i] = (const float*)d_in[i];
    p.out = (float*)d_out; p.ws = (unsigned char*)d_ws;
#if MK_COOP
    p.ph_lo = 0; p.ph_hi = NPHASE; p.coop = 1;
    (void)hipMemsetAsync((char*)d_ws + WS_CTL, 0, CTL_BYTES, stream);
    void* args[] = {&p};
    hipError_t e = hipLaunchCooperativeKernel((const void*)fwd_megakernel, dim3(grid), dim3(512), args, LDS_BYTES, stream);
    if (e != hipSuccess) fprintf(stderr, "cooperative launch failed: %s (grid %d)\n", hipGetErrorString(e), grid);
#else
    for (int ph = 0; ph < NPHASE; ++ph) {
        p.ph_lo = ph; p.ph_hi = ph + 1;
        hipLaunchKernelGGL(fwd_megakernel, dim3(grid), dim3(512), LDS_BYTES, stream, p);
    }
#endif
}
```

```cpp
#include <hip/hip_runtime.h>
#include <hip/hip_cooperative_groups.h>
#include <cstdio>
#include <cstdint>
namespace cg = cooperative_groups;

#ifndef MK_COOP
#define MK_COOP 1
#endif

#define DI __device__ __forceinline__
#define LAS __attribute__((address_space(3)))
typedef unsigned short bf16_t;
typedef short bf16x8 __attribute__((ext_vector_type(8)));
typedef float f32x2 __attribute__((ext_vector_type(2)));
typedef float f32x4 __attribute__((ext_vector_type(4)));
typedef float f32x16 __attribute__((ext_vector_type(16)));
typedef unsigned u32x2 __attribute__((ext_vector_type(2)));
typedef unsigned u32x4 __attribute__((ext_vector_type(4)));
typedef __bf16 bf16x2_t __attribute__((ext_vector_type(2)));

constexpr int D = 1024, T_CTX = 8192, T_LAT = 16384, T = T_CTX + T_LAT;
constexpr int LLAT = 4608, KR = T_CTX + 4 * LLAT;
constexpr int NZ = 1792, FF = 4096;
constexpr int MODW = 6144;
constexpr float EPS = 1e-6f;
constexpr float QSCALE = 0.10206207261596577f * 1.4426950408889634f;
constexpr size_t OUT_CKV = (size_t)T * D, OUT_KPE = OUT_CKV + (size_t)32 * 2 * 256 * 256;
constexpr size_t KF_CTX = (size_t)32 * 8 * 256 * 96, VT_CTX = (size_t)32 * 8 * 64 * 256;

constexpr size_t WS_WIN = 0;
constexpr size_t WS_WQB = WS_WIN + (size_t)2 * NZ * 1024 * 2;
constexpr size_t WS_WK = WS_WQB + (size_t)2 * 768 * 384 * 2;
constexpr size_t WS_WV = WS_WK + (size_t)2 * 512 * 256 * 2;
constexpr size_t WS_WOUT = WS_WV + (size_t)2 * 512 * 256 * 2;
constexpr size_t WS_WPOOL = WS_WOUT + (size_t)2 * 1024 * 1024 * 2;
constexpr size_t WS_WSP = WS_WPOOL + (size_t)2 * 1024 * 256 * 2;
constexpr size_t WS_WFF1 = WS_WSP + (size_t)2 * 8 * 128 * 128 * 2;
constexpr size_t WS_WFF2 = WS_WFF1 + (size_t)4 * FF * 1024 * 2;
constexpr size_t WS_MOD = WS_WFF2 + (size_t)4 * FF * 1024 * 2;
constexpr size_t WS_H = WS_MOD + (size_t)4 * 5 * MODW * 4;
constexpr size_t WS_U = WS_H + (size_t)T * 1024 * 2;
constexpr size_t WS_Z = WS_U;
constexpr size_t WS_QN = WS_Z + (size_t)T * NZ * 2;
constexpr size_t WS_CKV = WS_QN + (size_t)T * 384 * 2;
constexpr size_t WS_Q = WS_CKV + (size_t)KR * 256 * 2;
constexpr size_t WS_KF = WS_Q + (size_t)T * 768 * 2;
constexpr size_t WS_VT = WS_KF + (size_t)KR * 8 * 96 * 2;
constexpr size_t WS_VN = WS_VT + (size_t)KR * 512 * 2;
constexpr size_t WS_END1 = WS_VN + (size_t)T * 512 * 2;
constexpr size_t WS_FFH = WS_U;
constexpr size_t WS_PD = WS_U;
constexpr size_t WS_END2 = WS_FFH + (size_t)T * FF * 2;
constexpr size_t WS_DELTA = WS_END2;
static_assert(WS_DELTA + (size_t)T * 1024 * 2 <= WS_END1, "delta");
constexpr size_t WS_NEED = WS_END1 > WS_END2 ? WS_END1 : WS_END2;
static_assert(WS_NEED <= (size_t)402653184, "workspace map exceeds 4x largest tensor");

constexpr int XST_OFF = 131072;
constexpr int LDS_BYTES = 131072 + 64;
constexpr size_t WS_CTL = (WS_NEED + 255) & ~(size_t)255, CTL_BYTES = 32768;
constexpr size_t WS_KPE = WS_CTL + CTL_BYTES;
constexpr size_t WS_TOTAL = WS_KPE + (size_t)KR * 32 * 2;
static_assert(WS_TOTAL <= (size_t)402653184, "ctl");
constexpr int NPHASE = 32;

struct Params {
    const float* in[24];
    float* out;
    unsigned char* ws;
    int ph_lo, ph_hi;
    int coop, pad;
};
typedef const __attribute__((address_space(4))) Params* KP;
enum { I_XP = 0, I_XS, I_CCKV, I_CKPE, I_C, I_CCTX, I_WMOD, I_BMOD, I_N1G, I_N2G, I_WIN, I_QAG, I_KVAG, I_WQB, I_WKVB, I_VG, I_WSP, I_BSP, I_WOUT, I_WPOOL, I_PSCALE, I_WFF1, I_WFF2, I_FG };

DI unsigned pk_bf16(float lo, float hi) { f32x2 v = {lo, hi}; bf16x2_t b = __builtin_convertvector(v, bf16x2_t); return __builtin_bit_cast(unsigned, b); }
DI float bf_lo(unsigned u) { return __builtin_bit_cast(float, u << 16); }
DI float bf_hi(unsigned u) { return __builtin_bit_cast(float, u & 0xffff0000u); }
DI float bf1(bf16_t u) { return __builtin_bit_cast(float, (unsigned)u << 16); }
DI bf16_t f2bf(float f) { return (bf16_t)(pk_bf16(f, 0.f) & 0xffffu); }
DI float wave_sum(float v) {
#pragma unroll
    for (int o = 32; o; o >>= 1) v += __shfl_xor(v, o);
    return v;
}
DI int cond_of_row(int row) { return row < T_CTX ? 4 : ((row - T_CTX) >> 12); }
DI void sincos_rr(float x, float& s, float& c) {
    const float n = rintf(x * 0.15915494309189535f);
    float r = fmaf(-n, 6.2831854820251465f, x);
    r = fmaf(-n, -1.7484556000744883e-07f, r);
    s = __sinf(r); c = __cosf(r);
}
DI float rope_inv(int f) { return exp2f(-(float)f * 1.6609640474436813f); }
DI float gelu_tanh(float x) {
    const float u = 0.7978845608028654f * (x + 0.044715f * x * x * x);
    const float t = __builtin_amdgcn_exp2f(-2.885390081777927f * u);
    return x * __builtin_amdgcn_rcpf(1.f + t);
}

namespace pg8 {
constexpr int BM = 256, BK = 64, HALF = 128, HTB = HALF * BK * 2, NXCD = 8, WGM = 8;
DI int lds_byte(int r, int c) { const int st = (r >> 4) * 2 + (c >> 5), rr = r & 15, cc = c & 31, ob = rr * 64 + cc * 2; return st * 1024 + (ob ^ (((ob >> 9) & 1) << 5)); }
DI void stage_rc(int b, int& R, int& C) { const int st = b / 1024, sb = b % 1024, swz = sb ^ (((sb >> 9) & 1) << 5); R = (st >> 1) * 16 + swz / 64; C = (st & 1) * 32 + (swz % 64) / 2; }
DI int perm32(int rho) { const int n = rho >> 4, i = rho & 15; return 8 * (i >> 2) + 4 * n + (i & 3); }
struct Unit { int pm, pn, kt0, nt, role, slot, mh; };
struct Gemm { const bf16_t* A; const bf16_t* Bt; int lda, ldb, K, a_pn_step, nM, nN, rot; float* P; unsigned* flags; int tiledA, tiledB, msplit; };

DI bool next_unit(int bid_o, const Gemm& g, int i, Unit& u) {
    const int G = gridDim.x; int c = bid_o + g.rot; if (c >= G) c -= G;
    const int nwg = g.nM * g.nN, ntf = g.K / BK;
    const int R = nwg / G, r = nwg - R * G;
    const bool split = g.P != nullptr && r > 0 && 2 * r <= G;
    long L; u.kt0 = 0; u.nt = ntf; u.role = 0; u.slot = 0; u.mh = 0;
    const bool msp = g.msplit && r > 0 && 2 * r <= G;
    if (msp) {
        if (i < R) L = (long)i * G + c;
        else if (i == R && c < 2 * r) { L = (long)R * G + (c >> 1); u.mh = 1 + (c & 1); }
        else return false;
    } else
    if (split && c < 2 * r) {
        const bool prod = (c & 1) == 0;
        if (i > R) return false;
        if (prod ? (i == 0) : (i == R)) { L = (long)R * G + (c >> 1); u.nt = ntf / 2; u.kt0 = prod ? 0 : ntf / 2; u.role = prod ? 1 : 2; u.slot = c >> 1; }
        else L = (long)(prod ? i - 1 : i) * G + c;
    } else {
        L = (long)i * G + c;
        if (split ? (i >= R) : (L >= nwg)) return false;
    }
    int wgid = (int)L; { const int q = nwg / NXCD, rr = nwg % NXCD, xcd = wgid % NXCD, off = wgid / NXCD; wgid = (xcd < rr ? xcd * (q + 1) : rr * (q + 1) + (xcd - rr) * q) + off; }
    const int nig = WGM * g.nN, gid = wgid / nig, fm = gid * WGM, gsz = (g.nM - fm) < WGM ? (g.nM - fm) : WGM;
    u.pm = fm + ((wgid % nig) % gsz); u.pn = (wgid % nig) / gsz; return true;
}

template <class EpiT>
DI void gemm_phase(int tid_o, int bid_o, LAS unsigned char* lds, const Gemm g, const EpiT& E) {
    const int tid = tid_o, wid = __builtin_amdgcn_readfirstlane(tid >> 6), lane = tid & 63, wr = wid >> 2, wc = wid & 3, fr = lane & 15, fq = lane >> 4;
    const int ldaE = g.tiledA ? 64 : g.lda, ldbE = g.tiledB ? 64 : g.ldb;
    unsigned voffA[2], voffB[2];
#pragma unroll
    for (int i = 0; i < 2; ++i) { int R, C; stage_rc(tid * 16 + i * 8192, R, C); const int Rb = (R & ~31) + perm32(R & 31);
        voffA[i] = (unsigned)(R * ldaE + C) * 2u; voffB[i] = (unsigned)(Rb * ldbE + C) * 2u; }
    const size_t kstepA = g.tiledA ? 32768 : 128, kstepB = g.tiledB ? 32768 : 128;
    const size_t hstepA = (size_t)HALF * ldaE * 2, hstepB = (size_t)HALF * ldbE * 2;
    const size_t tstepA = g.tiledA ? (size_t)512 * g.K : 2 * hstepA, tstepB = g.tiledB ? (size_t)512 * g.K : 2 * hstepB;
    const unsigned ldsw = (unsigned)wid * 1024u;
    const int aoff = lds_byte(wr * 64 + fr, fq * 8), boff = lds_byte(wc * 32 + fr, fq * 8);
#define PG8_SA(b, h) (((b) * 2 + (h)) * HTB)
#define PG8_SB(b, h) ((4 + (b) * 2 + (h)) * HTB)
#define PG8_STAGE(bufoff, gbase, voff) do { _Pragma("unroll") for (int _i = 0; _i < 2; ++_i) \
        __builtin_amdgcn_global_load_lds((const unsigned*)((const char*)(gbase) + (voff)[_i]), (LAS unsigned*)(lds + (bufoff) + ldsw + _i * 8192), 16, 0, 0); } while (0)
#define PG8_LDA(dst, b, h) do { _Pragma("unroll") for (int m = 0; m < 4; ++m) _Pragma("unroll") for (int k = 0; k < 2; ++k) dst[m][k] = *(const LAS bf16x8*)(lds + PG8_SA(b, h) + aoff + m * 2048 + k * 1024); } while (0)
#define PG8_LDB(dst, b, h) do { _Pragma("unroll") for (int n = 0; n < 2; ++n) _Pragma("unroll") for (int k = 0; k < 2; ++k) dst[n][k] = *(const LAS bf16x8*)(lds + PG8_SB(b, h) + boff + n * 2048 + k * 1024); } while (0)
#define PG8_MMA(ai, bj, At, Bt) do { __builtin_amdgcn_s_setprio(1); _Pragma("unroll") for (int m = 0; m < 4; ++m) _Pragma("unroll") for (int n = 0; n < 2; ++n) _Pragma("unroll") for (int k = 0; k < 2; ++k) \
        acc[ai][bj][m][n] = __builtin_amdgcn_mfma_f32_16x16x32_bf16(Bt[n][k], At[m][k], acc[ai][bj][m][n], 0, 0, 0); __builtin_amdgcn_s_setprio(0); } while (0)
#define PG8_WAIT_V(n) asm volatile("s_waitcnt vmcnt(" #n ")" ::: "memory")
#define PG8_WAIT_L(n) asm volatile("s_waitcnt lgkmcnt(" #n ")" ::: "memory")
#define PG8_BAR __builtin_amdgcn_s_barrier()
#define PG8_SCHED __builtin_amdgcn_sched_barrier(0)
    Unit cur, nxt; int ui = 0;
    if (!next_unit(bid_o, g, 0, cur)) return;
    f32x4 acc[2][2][4][2];
#pragma unroll
    for (int a = 0; a < 2; ++a)
#pragma unroll
        for (int b = 0; b < 2; ++b)
#pragma unroll
            for (int m = 0; m < 4; ++m)
#pragma unroll
                for (int n = 0; n < 2; ++n) acc[a][b][m][n] = (f32x4){0.f, 0.f, 0.f, 0.f};
    bf16x8 At[4][2], B0[2][2], B1[2][2];
    const char* cA = (const char*)g.A + (size_t)cur.pm * tstepA + (size_t)cur.pn * g.a_pn_step * 2 + (size_t)cur.kt0 * kstepA + (cur.mh == 2 ? hstepA : 0); const char* cB = (const char*)g.Bt + (size_t)cur.pn * tstepB + (size_t)cur.kt0 * kstepB;
    PG8_STAGE(PG8_SB(0, 0), cB, voffB); PG8_STAGE(PG8_SB(0, 1), cB + hstepB, voffB); PG8_STAGE(PG8_SA(0, 0), cA, voffA); PG8_STAGE(PG8_SA(0, 1), cA + (cur.mh ? 0 : hstepA), voffA);
    if (wr == 1) PG8_BAR;
    PG8_WAIT_V(2); PG8_BAR;
    PG8_STAGE(PG8_SB(1, 0), cB + kstepB, voffB); PG8_STAGE(PG8_SA(1, 0), cA + kstepA, voffA); PG8_STAGE(PG8_SB(1, 1), cB + hstepB + kstepB, voffB);
    PG8_WAIT_V(6); PG8_BAR;
    for (;;) {
        const bool has_next = next_unit(bid_o, g, ui + 1, nxt);
        const char* nA = has_next ? (const char*)g.A + (size_t)nxt.pm * tstepA + (size_t)nxt.pn * g.a_pn_step * 2 + (size_t)nxt.kt0 * kstepA + (nxt.mh == 2 ? hstepA : 0) : cA;
        const size_t hAc = cur.mh ? 0 : hstepA, hAn = has_next ? (nxt.mh ? 0 : hstepA) : hAc;
        const bool fullM = cur.mh == 0; const char* nB = has_next ? (const char*)g.Bt + (size_t)nxt.pn * tstepB + (size_t)nxt.kt0 * kstepB : cB;
        const int nt = cur.nt;
#pragma nounroll
        for (int t = 0; t < nt; t += 2) {
            const bool last = (t == nt - 2);
            const char* a1 = cA + (size_t)(t + 1) * kstepA;
            const char* a2 = last ? nA : cA + (size_t)(t + 2) * kstepA; const char* b2 = last ? nB : cB + (size_t)(t + 2) * kstepB;
            const char* a3 = a2 + kstepA; const char* b3 = b2 + kstepB;
            PG8_LDB(B0, 0, 0); PG8_LDB(B1, 0, 1); PG8_SCHED; PG8_LDA(At, 0, 0); PG8_STAGE(PG8_SA(1, 1), a1 + hAc, voffA);
            PG8_WAIT_V(8); PG8_WAIT_L(0); PG8_BAR; PG8_MMA(0, 0, At, B0); PG8_MMA(0, 1, At, B1); PG8_BAR; PG8_SCHED;
            PG8_LDA(At, 0, 1); PG8_STAGE(PG8_SB(0, 0), b2, voffB); PG8_STAGE(PG8_SB(0, 1), b2 + hstepB, voffB); PG8_STAGE(PG8_SA(0, 0), a2, voffA);
            PG8_WAIT_V(8); PG8_WAIT_L(0); PG8_BAR; if (fullM) { PG8_MMA(1, 0, At, B0); PG8_MMA(1, 1, At, B1); } PG8_BAR; PG8_SCHED;
            PG8_LDB(B0, 1, 0); PG8_LDB(B1, 1, 1); PG8_SCHED; PG8_LDA(At, 1, 0); PG8_STAGE(PG8_SA(0, 1), a2 + (last ? hAn : hAc), voffA);
            PG8_WAIT_V(8); PG8_WAIT_L(0); PG8_BAR; PG8_MMA(0, 0, At, B0); PG8_MMA(0, 1, At, B1); PG8_BAR; PG8_SCHED;
            PG8_LDA(At, 1, 1); PG8_STAGE(PG8_SB(1, 0), b3, voffB); PG8_STAGE(PG8_SB(1, 1), b3 + hstepB, voffB); PG8_STAGE(PG8_SA(1, 0), a3, voffA);
            PG8_WAIT_V(8); PG8_WAIT_L(0); PG8_BAR; if (fullM) { PG8_MMA(1, 0, At, B0); PG8_MMA(1, 1, At, B1); } PG8_BAR; PG8_SCHED;
        }
        if (wr == 0) PG8_BAR;
        if (cur.role == 1) {
            float* pp = g.P + (size_t)cur.slot * 65536 + tid * 4;
#pragma unroll
            for (int a = 0; a < 2; ++a)
#pragma unroll
                for (int b = 0; b < 2; ++b)
#pragma unroll
                    for (int m = 0; m < 4; ++m)
#pragma unroll
                        for (int n = 0; n < 2; ++n) *(f32x4*)(pp + (size_t)(((a * 2 + b) * 4 + m) * 2 + n) * 2048) = acc[a][b][m][n];
            asm volatile("s_waitcnt vmcnt(0)" ::: "memory");
            __syncthreads();
            if (tid == 0) { __builtin_amdgcn_fence(__ATOMIC_RELEASE, "agent"); asm volatile("s_waitcnt vmcnt(0)" ::: "memory"); __hip_atomic_fetch_add(g.flags + cur.slot, 1u, __ATOMIC_RELAXED, __HIP_MEMORY_SCOPE_AGENT); }
        } else {
            if (cur.role == 2) {
                if (tid == 0) {
                    unsigned sp = 0;
                    while (__hip_atomic_load(g.flags + cur.slot, __ATOMIC_RELAXED, __HIP_MEMORY_SCOPE_AGENT) == 0u) { __builtin_amdgcn_s_sleep(1); if (++sp > (1u << 24)) break; }
                    __builtin_amdgcn_fence(__ATOMIC_ACQUIRE, "agent"); asm volatile("s_waitcnt vmcnt(0)" ::: "memory");
                }
                __syncthreads();
            }
            E(acc, cur, wr, wc, fr, fq, cur.role == 2 ? g.P + (size_t)cur.slot * 65536 + tid * 4 : (const float*)nullptr);
        }
        if (!has_next) break;
#pragma unroll
        for (int a = 0; a < 2; ++a)
#pragma unroll
            for (int b = 0; b < 2; ++b)
#pragma unroll
                for (int m = 0; m < 4; ++m)
#pragma unroll
                    for (int n = 0; n < 2; ++n) acc[a][b][m][n] = (f32x4){0.f, 0.f, 0.f, 0.f};
        cur = nxt; cA = nA; cB = nB; ++ui;
        if (wr == 1) PG8_BAR;
    }
    PG8_WAIT_V(0);
    PG8_BAR;
#undef PG8_SA
#undef PG8_SB
#undef PG8_STAGE
#undef PG8_LDA
#undef PG8_LDB
#undef PG8_MMA
#undef PG8_WAIT_V
#undef PG8_WAIT_L
#undef PG8_BAR
#undef PG8_SCHED
}
}

enum { EM_Z = 0, EM_Q, EM_K, EM_VT, EM_RES, EM_FF1 };
template <int mode> struct Epi {
    bf16_t* O;
    float* X;
    const float* xin0; const float* xin1;
    const float* gate;
    const float* cscale;
    const bf16_t* kpe;
    DI void operator()(const f32x4 (&acc)[2][2][4][2], const pg8::Unit& u, int wr, int wc, int fr, int fq, const float* part) const {
        const int row0 = u.pm * 256 + wr * 64 + fr;
        const int col0 = u.pn * 256 + wc * 32 + 8 * fq;
        if (mode == EM_Z || mode == EM_FF1) {
            const int ld = mode == EM_Z ? NZ : FF;
            const bool gel = (mode == EM_Z) && (u.pn >= 3);
            const bool sq = (mode == EM_FF1);
#pragma unroll
            for (int ai = 0; ai < 2; ++ai)
#pragma unroll
                for (int m = 0; m < 4; ++m) {
                    bf16_t* rowp = sq ? O + (size_t)u.pm * 256 * FF + (size_t)(u.pn * 4 + (wc >> 1)) * 16384 + (size_t)(wr * 64 + fr + ai * 128 + m * 16) * 64 + (wc & 1) * 32 + 8 * fq
                                     : O + (size_t)(row0 + ai * 128 + m * 16) * ld + col0;
#pragma unroll
                    for (int bj = 0; bj < 2; ++bj) {
                        f32x4 v0 = acc[ai][bj][m][0], v1 = acc[ai][bj][m][1];
                        if (gel) {
#pragma unroll
                            for (int e = 0; e < 4; ++e) { v0[e] = gelu_tanh(v0[e]); v1[e] = gelu_tanh(v1[e]); }
                        }
                        if (sq) {
#pragma unroll
                            for (int e = 0; e < 4; ++e) { float a = fmaxf(v0[e], 0.f), b = fmaxf(v1[e], 0.f); v0[e] = a * a; v1[e] = b * b; }
                        }
                        u32x4 w; w.x = pk_bf16(v0[0], v0[1]); w.y = pk_bf16(v0[2], v0[3]); w.z = pk_bf16(v1[0], v1[1]); w.w = pk_bf16(v1[2], v1[3]);
                        *(u32x4*)(rowp + (sq ? bj * 2 * 16384 : bj * 128)) = w;
                    }
                }
        } else if (mode == EM_Q) {
#pragma unroll
            for (int bj = 0; bj < 2; ++bj) {
                const int c = col0 + bj * 128;
                const int j0 = c % 96;
                const bool rope_cols = j0 >= 64;
                const int jj0 = j0 - 64, ax = jj0 >> 4, fbase = (jj0 & 15) >> 1;
                float inv[4];
#pragma unroll
                for (int e = 0; e < 4; ++e) inv[e] = rope_inv(fbase + e);
#pragma unroll
                for (int ai = 0; ai < 2; ++ai)
#pragma unroll
                    for (int m = 0; m < 4; ++m) {
                        const int row = row0 + ai * 128 + m * 16;
                        f32x4 v0 = acc[ai][bj][m][0] * QSCALE, v1 = acc[ai][bj][m][1] * QSCALE;
                        if (rope_cols && row >= T_CTX) {
                            const int tt = (row - T_CTX) & 4095;
                            const float pos = (float)(ax == 0 ? (tt >> 6) : (tt & 63));
                            float s, cs, a, b;
                            sincos_rr(pos * inv[0], s, cs); a = v0[0]; b = v0[1]; v0[0] = a * cs - b * s; v0[1] = b * cs + a * s;
                            sincos_rr(pos * inv[1], s, cs); a = v0[2]; b = v0[3]; v0[2] = a * cs - b * s; v0[3] = b * cs + a * s;
                            sincos_rr(pos * inv[2], s, cs); a = v1[0]; b = v1[1]; v1[0] = a * cs - b * s; v1[1] = b * cs + a * s;
                            sincos_rr(pos * inv[3], s, cs); a = v1[2]; b = v1[3]; v1[2] = a * cs - b * s; v1[3] = b * cs + a * s;
                        }
                        u32x4 w; w.x = pk_bf16(v0[0], v0[1]); w.y = pk_bf16(v0[2], v0[3]); w.z = pk_bf16(v1[0], v1[1]); w.w = pk_bf16(v1[2], v1[3]);
                        *(u32x4*)(O + (size_t)row * 768 + c) = w;
                    }
            }
        } else if (mode == EM_K) {
            const int kr0 = u.pm * 256;
            size_t base; int L, l0;
            if (kr0 < T_CTX) { const int b = kr0 >> 8; L = 256; l0 = 0; base = (size_t)b * 8 * 256 * 96; }
            else { const int kk = kr0 - T_CTX, b = kk / LLAT; L = LLAT; l0 = kk - b * LLAT; base = KF_CTX + (size_t)b * 8 * LLAT * 96; }
#pragma unroll
            for (int bj = 0; bj < 2; ++bj) {
                const int c = col0 + bj * 128, h = c >> 6, j = c & 63;
#pragma unroll
                for (int ai = 0; ai < 2; ++ai)
#pragma unroll
                    for (int m = 0; m < 4; ++m) {
                        const int l = l0 + wr * 64 + fr + ai * 128 + m * 16;
                        const f32x4 v0 = acc[ai][bj][m][0], v1 = acc[ai][bj][m][1];
                        u32x4 w; w.x = pk_bf16(v0[0], v0[1]); w.y = pk_bf16(v0[2], v0[3]); w.z = pk_bf16(v1[0], v1[1]); w.w = pk_bf16(v1[2], v1[3]);
                        *(u32x4*)(O + base + ((size_t)h * L + l) * 96 + j) = w;
                    }
            }
            {
                const int tid = (wr * 4 + wc) * 64 + fq * 16 + fr;
#pragma unroll
                for (int q2 = 0; q2 < 2; ++q2) {
                    const int pr = tid + 512 * q2, r = pr & 255, h = u.pn * 4 + (pr >> 8);
                    const u32x4* src = (const u32x4*)(kpe + (size_t)(kr0 + r) * 32);
                    u32x4* dst = (u32x4*)(O + base + ((size_t)h * L + l0 + r) * 96 + 64);
                    const u32x4 c0 = src[0], c1 = src[1], c2 = src[2], c3 = src[3];
                    dst[0] = c0; dst[1] = c1; dst[2] = c2; dst[3] = c3;
                }
            }
        } else if (mode == EM_VT) {
            const int kr0 = u.pn * 256;
            size_t base; int L, l0;
            if (kr0 < T_CTX) { const int b = kr0 >> 8; L = 256; l0 = 0; base = (size_t)b * 8 * 64 * 256; }
            else { const int kk = kr0 - T_CTX, b = kk / LLAT; L = LLAT; l0 = kk - b * LLAT; base = VT_CTX + (size_t)b * 8 * 64 * LLAT; }
#pragma unroll
            for (int ai = 0; ai < 2; ++ai)
#pragma unroll
                for (int m = 0; m < 4; ++m) {
                    const int f = row0 + ai * 128 + m * 16;
#pragma unroll
                    for (int bj = 0; bj < 2; ++bj) {
                        const int l = l0 + wc * 32 + 8 * fq + bj * 128;
                        const f32x4 v0 = acc[ai][bj][m][0], v1 = acc[ai][bj][m][1];
                        u32x4 w; w.x = pk_bf16(v0[0], v0[1]); w.y = pk_bf16(v0[2], v0[3]); w.z = pk_bf16(v1[0], v1[1]); w.w = pk_bf16(v1[2], v1[3]);
                        *(u32x4*)(O + base + (size_t)f * L + l) = w;
                    }
                }
        } else {
            typedef _Float16 h16x8_t __attribute__((ext_vector_type(8)));
            typedef float f32x8_t __attribute__((ext_vector_type(8)));
            _Float16* X = (_Float16*)O;
            const int b = cond_of_row(u.pm * 256);
            const float* gp = gate + (size_t)b * MODW;
#pragma unroll
            for (int bj = 0; bj < 2; ++bj) {
                const int c = col0 + bj * 128;
                f32x4 g0 = *(const f32x4*)(gp + c), g1 = *(const f32x4*)(gp + c + 4);
                if (cscale) { g0 = g0 * *(const f32x4*)(cscale + c); g1 = g1 * *(const f32x4*)(cscale + c + 4); }
                h16x8_t xv[2][4];
#pragma unroll
                for (int ai = 0; ai < 2; ++ai)
#pragma unroll
                    for (int m = 0; m < 4; ++m) {
                        if (ai == 1 && u.mh) continue;
                        const int row = row0 + (u.mh == 2 ? 128 : 0) + ai * 128 + m * 16;
                        xv[ai][m] = *(const h16x8_t*)(X + (size_t)row * D + c);
                    }
#pragma unroll
                for (int ai = 0; ai < 2; ++ai)
#pragma unroll
                    for (int m = 0; m < 4; ++m) {
                        if (ai == 1 && u.mh) continue;
                        const int row = row0 + (u.mh == 2 ? 128 : 0) + ai * 128 + m * 16;
                        const f32x4 a0 = acc[ai][bj][m][0] * g0, a1 = acc[ai][bj][m][1] * g1;
                        f32x8_t xf = __builtin_convertvector(xv[ai][m], f32x8_t);
                        xf[0] += a0[0]; xf[1] += a0[1]; xf[2] += a0[2]; xf[3] += a0[3]; xf[4] += a1[0]; xf[5] += a1[1]; xf[6] += a1[2]; xf[7] += a1[3];
                        *(h16x8_t*)(X + (size_t)row * D + c) = __builtin_convertvector(xf, h16x8_t);
                    }
            }
        }
    }
};

struct TDesc { const float* src; bf16_t* dst; int ld, K, N, perm, tiled; };
DI int tperm(int perm, int n) {
    if (perm == 0) return n;
    if (perm == 1) return n < 672 ? n : (n < 768 ? -1 : n - 96);
    if (perm == 2) { const int h = n / 96, j = n - h * 96; if (j < 64) return n; const int jj = j - 64, a = jj >> 4, r = jj & 15, f = r >> 1, pp = r & 1; return h * 96 + 64 + a * 16 + pp * 8 + f; }
    if (perm == 3) return (n >> 6) * 128 + (n & 63);
    return (n >> 6) * 128 + 64 + (n & 63);
}
DI bool tdesc_find(KP p, int tile, TDesc& d, int& local) {
    int t = tile;
#define TD_TRY(SRC, DST, LD, KK, NN, PERM) { const int cnt = ((KK) / 64) * ((NN) / 32); if (t < cnt) { d.src = (SRC); d.dst = (DST); d.ld = (LD); d.K = (KK); d.N = (NN); d.perm = (PERM) & 15; d.tiled = (PERM) >> 4; local = t; return true; } t -= cnt; }
    for (int i = 0; i < 4; ++i) TD_TRY(p->in[I_WFF1] + (size_t)i * 1024 * FF, (bf16_t*)(p->ws + WS_WFF1) + (size_t)i * FF * 1024, FF, 1024, FF, 0)
    for (int i = 0; i < 4; ++i) TD_TRY(p->in[I_WFF2] + (size_t)i * FF * 1024, (bf16_t*)(p->ws + WS_WFF2) + (size_t)i * 1024 * FF, 1024, FF, 1024, 16)
    for (int i = 0; i < 2; ++i) TD_TRY(p->in[I_WIN] + (size_t)i * 1024 * 1696, (bf16_t*)(p->ws + WS_WIN) + (size_t)i * NZ * 1024, 1696, 1024, NZ, 1)
    for (int i = 0; i < 2; ++i) TD_TRY(p->in[I_WOUT] + (size_t)i * 1024 * 1024, (bf16_t*)(p->ws + WS_WOUT) + (size_t)i * 1024 * 1024, 1024, 1024, 1024, 0)
    for (int i = 0; i < 2; ++i) TD_TRY(p->in[I_WQB] + (size_t)i * 384 * 768, (bf16_t*)(p->ws + WS_WQB) + (size_t)i * 768 * 384, 768, 384, 768, 2)
    for (int i = 0; i < 2; ++i) TD_TRY(p->in[I_WKVB] + (size_t)i * 256 * 1024, (bf16_t*)(p->ws + WS_WK) + (size_t)i * 512 * 256, 1024, 256, 512, 3)
    for (int i = 0; i < 2; ++i) TD_TRY(p->in[I_WKVB] + (size_t)i * 256 * 1024, (bf16_t*)(p->ws + WS_WV) + (size_t)i * 512 * 256, 1024, 256, 512, 4)
    for (int i = 0; i < 8; ++i) TD_TRY(p->in[I_WPOOL] + (size_t)i * 256 * 256, (bf16_t*)(p->ws + WS_WPOOL) + (size_t)i * 256 * 256, 256, 256, 256, 0)
#undef TD_TRY
    return false;
}
constexpr int N_TITEMS = 2 * 896 + 2 * 144 + 2 * 64 + 2 * 64 + 2 * 512 + 8 * 32 + 4 * 2048 + 4 * 2048;
constexpr int N_MODU = 4 * 48;

DI void prologue_phase(int tid_o, int bid_o, KP p, LAS unsigned char* lds) {
    const int tid = tid_o, wid = tid >> 6, lane = tid & 63;
    LAS float* lf = (LAS float*)lds;
    for (int u = bid_o; u < N_MODU; u += gridDim.x) {
        const int l = u / 48, cb = u % 48;
        LAS float* sl = lf;
        LAS float* red = lf + 5120;
        for (int idx = tid; idx < 5120; idx += 512) { const int r = idx >> 10, k = idx & 1023; const float c = r < 4 ? p->in[I_C][r * 1024 + k] : p->in[I_CCTX][k]; sl[idx] = c / (1.f + __expf(-c)); }
        __syncthreads();
        float a[5][2];
#pragma unroll
        for (int r = 0; r < 5; ++r) { a[r][0] = 0.f; a[r][1] = 0.f; }
        const float* wp = p->in[I_WMOD] + ((size_t)l * 1024 + wid * 128) * MODW + cb * 128 + lane * 2;
#pragma unroll 16
        for (int kk = 0; kk < 128; ++kk) {
            const f32x2 wv = __builtin_nontemporal_load((const f32x2*)(wp + (size_t)kk * MODW));
#pragma unroll
            for (int r = 0; r < 5; ++r) { const float s = sl[r * 1024 + wid * 128 + kk]; a[r][0] += s * wv.x; a[r][1] += s * wv.y; }
        }
#pragma unroll
        for (int r = 0; r < 5; ++r) { red[(wid * 5 + r) * 128 + lane * 2] = a[r][0]; red[(wid * 5 + r) * 128 + lane * 2 + 1] = a[r][1]; }
        __syncthreads();
        for (int idx = tid; idx < 640; idx += 512) {
            const int r = idx >> 7, c = idx & 127; float s = p->in[I_BMOD][l * MODW + cb * 128 + c];
#pragma unroll
            for (int w = 0; w < 8; ++w) s += red[(w * 5 + r) * 128 + c];
            ((float*)(p->ws + WS_MOD))[(size_t)(l * 5 + r) * MODW + cb * 128 + c] = s;
        }
        __syncthreads();
    }
    for (int idx = bid_o * 512 + tid; idx < 32768; idx += gridDim.x * 512) {
        const int e0 = idx * 8;
        const f32x4 a = *(const f32x4*)(p->in[I_WSP] + e0), b = *(const f32x4*)(p->in[I_WSP] + e0 + 4);
        u32x4 w; w.x = pk_bf16(a[0], a[1]); w.y = pk_bf16(a[2], a[3]); w.z = pk_bf16(b[0], b[1]); w.w = pk_bf16(b[2], b[3]);
        *(u32x4*)((bf16_t*)(p->ws + WS_WSP) + e0) = w;
    }
    LAS float* sc = (LAS float*)(lds + 40960 + wid * 8448);
    const int G = gridDim.x;
    const bool lowb = bid_o < N_MODU && G > N_MODU;
    const int pool0 = G > N_MODU ? (N_TITEMS / 32) * 21 : N_TITEMS;
    const int it_begin = lowb ? bid_o * 8 + wid : (G > N_MODU ? pool0 + (bid_o - N_MODU) * 8 + wid : bid_o * 8 + wid);
    const int it_end = lowb ? pool0 : N_TITEMS;
    const int it_step = lowb ? N_MODU * 8 : (G > N_MODU ? (G - N_MODU) * 8 : G * 8);
    for (int it = it_begin; it < it_end; it += it_step) {
        TDesc d; int local;
        if (!tdesc_find(p, it, d, local)) continue;
        const int tiles_n = d.N / 32, tn = local % tiles_n, tk = local / tiles_n, n0 = tn * 32, k0 = tk * 64;
        { const int c = lane & 31, kh = lane >> 5; const int scol = tperm(d.perm, n0 + c);
            const float* sp = d.src + (size_t)(k0 + kh * 32) * d.ld + (scol >= 0 ? scol : 0);
            float v[32];
#pragma unroll
            for (int j = 0; j < 32; ++j) v[j] = scol >= 0 ? __builtin_nontemporal_load(sp + (size_t)j * d.ld) : 0.f;
#pragma unroll
            for (int j = 0; j < 32; ++j) sc[(kh * 32 + j) * 33 + c] = v[j]; }
        { const int ch = lane & 7, n = lane >> 3;
#pragma unroll
            for (int j4 = 0; j4 < 4; ++j4) { const int nn = n + 8 * j4; const LAS float* q = sc + (8 * ch) * 33 + nn;
                u32x4 o; o.x = pk_bf16(q[0 * 33], q[1 * 33]); o.y = pk_bf16(q[2 * 33], q[3 * 33]); o.z = pk_bf16(q[4 * 33], q[5 * 33]); o.w = pk_bf16(q[6 * 33], q[7 * 33]);
                bf16_t* dp = d.tiled ? d.dst + ((size_t)((n0 + nn) >> 8) * (d.K / 64) + tk) * 16384 + (size_t)((n0 + nn) & 255) * 64 + 8 * ch : d.dst + (size_t)(n0 + nn) * d.K + k0 + 8 * ch;
                *(u32x4*)dp = o; } }
    }
}

typedef _Float16 h16x4 __attribute__((ext_vector_type(4)));
DI void norm_phase(int tid_o, int bid_o, KP p, int layer, int which, bool first, bool final_) {
    const int wid = tid_o >> 6, lane = tid_o & 63;
    const float* gw = final_ ? p->in[I_FG] : (which == 0 ? p->in[I_N1G] : p->in[I_N2G]) + layer * D;
    bf16_t* H = (bf16_t*)(p->ws + WS_DELTA);
    _Float16* X16 = (_Float16*)(p->ws + WS_H);
    constexpr int NR = 4;
    for (int row0 = (bid_o * 8 + wid) * NR; row0 < T; row0 += gridDim.x * 8 * NR) {
        f32x4 v[NR][4];
        if (first) {
#pragma unroll
            for (int r = 0; r < NR; ++r) {
                const int row = row0 + r;
                const float* xr = row < T_CTX ? p->in[I_XP] + (size_t)row * D : p->in[I_XS] + (size_t)(row - T_CTX) * D;
#pragma unroll
                for (int j = 0; j < 4; ++j) v[r][j] = *(const f32x4*)(xr + j * 256 + lane * 4);
            }
        } else {
#pragma unroll
            for (int r = 0; r < NR; ++r)
#pragma unroll
                for (int j = 0; j < 4; ++j) v[r][j] = __builtin_convertvector(*(const h16x4*)(X16 + (size_t)(row0 + r) * D + j * 256 + lane * 4), f32x4);
        }
        float ss[NR];
#pragma unroll
        for (int r = 0; r < NR; ++r) {
            ss[r] = 0.f;
#pragma unroll
            for (int j = 0; j < 4; ++j) ss[r] += v[r][j][0] * v[r][j][0] + v[r][j][1] * v[r][j][1] + v[r][j][2] * v[r][j][2] + v[r][j][3] * v[r][j][3];
        }
#pragma unroll
        for (int o = 32; o; o >>= 1)
#pragma unroll
            for (int r = 0; r < NR; ++r) ss[r] += __shfl_xor(ss[r], o);
        float rs[NR];
#pragma unroll
        for (int r = 0; r < NR; ++r) rs[r] = rsqrtf(ss[r] * (1.f / D) + EPS);
        if (final_) {
#pragma unroll
            for (int j = 0; j < 4; ++j) {
                const int c = j * 256 + lane * 4; const f32x4 g4 = *(const f32x4*)(gw + c);
#pragma unroll
                for (int r = 0; r < NR; ++r) *(f32x4*)(p->out + (size_t)(row0 + r) * D + c) = v[r][j] * rs[r] * g4;
            }
        } else {
            if (first) {
#pragma unroll
                for (int r = 0; r < NR; ++r)
#pragma unroll
                    for (int j = 0; j < 4; ++j) *(h16x4*)(X16 + (size_t)(row0 + r) * D + j * 256 + lane * 4) = __builtin_convertvector(v[r][j], h16x4);
            }
            const float* md = (const float*)(p->ws + WS_MOD) + (size_t)(layer * 5 + cond_of_row(row0)) * MODW + (which ? 3 * D : 0);
#pragma unroll
            for (int j = 0; j < 4; ++j) {
                const int c = j * 256 + lane * 4;
                const f32x4 g4 = *(const f32x4*)(gw + c), sh = *(const f32x4*)(md + c), sc = *(const f32x4*)(md + D + c);
                const f32x4 gm = g4 * (sc + 1.f);
#pragma unroll
                for (int r = 0; r < NR; ++r) {
                    const f32x4 y = v[r][j] * rs[r] * gm + sh;
                    u32x2 w; w.x = pk_bf16(y[0], y[1]); w.y = pk_bf16(y[2], y[3]);
                    *(u32x2*)(H + (size_t)(row0 + r) * D + c) = w;
                }
            }
        }
    }
}

DI void rowop_phase(int tid_o, int bid_o, KP p, int i) {
    const int wid = tid_o >> 6, lane = tid_o & 63;
    const bf16_t* Z = (const bf16_t*)(p->ws + WS_Z);
    bf16_t* QN = (bf16_t*)(p->ws + WS_QN); bf16_t* CKV = (bf16_t*)(p->ws + WS_CKV); bf16_t* KPE = (bf16_t*)(p->ws + WS_KPE); bf16_t* VN = (bf16_t*)(p->ws + WS_VN);
    const float* qag = p->in[I_QAG] + i * 384; const float* kvg = p->in[I_KVAG] + i * 256; const float* vg = p->in[I_VG] + i * 512;
    constexpr int NR = 4;
    for (int it0 = (bid_o * 8 + wid) * NR; it0 < T; it0 += gridDim.x * 8 * NR) {
        u32x2 zz[NR][5];
#pragma unroll
        for (int r = 0; r < NR; ++r) {
            const bf16_t* zr = Z + (size_t)(it0 + r) * NZ;
            zz[r][0] = *(const u32x2*)(zr + 4 * lane); zz[r][1] = *(const u32x2*)(zr + 4 * (64 + lane)); zz[r][2] = *(const u32x2*)(zr + 4 * (128 + (lane < 40 ? lane : 0)));
            zz[r][3] = *(const u32x2*)(zr + 4 * (320 + lane)); zz[r][4] = *(const u32x2*)(zr + 4 * (384 + lane));
        }
#pragma unroll
        for (int r = 0; r < NR; ++r) {
            const int row = it0 + r;
            const u32x2 z0 = zz[r][0], z1 = zz[r][1], z2 = zz[r][2], z5 = zz[r][3], z6 = zz[r][4];
            float a0[4] = {bf_lo(z0.x), bf_hi(z0.x), bf_lo(z0.y), bf_hi(z0.y)};
            float a1[4] = {bf_lo(z1.x), bf_hi(z1.x), bf_lo(z1.y), bf_hi(z1.y)};
            float a2[4] = {bf_lo(z2.x), bf_hi(z2.x), bf_lo(z2.y), bf_hi(z2.y)};
            float a5[4] = {bf_lo(z5.x), bf_hi(z5.x), bf_lo(z5.y), bf_hi(z5.y)};
            float a6[4] = {bf_lo(z6.x), bf_hi(z6.x), bf_lo(z6.y), bf_hi(z6.y)};
            const float s0 = a0[0] * a0[0] + a0[1] * a0[1] + a0[2] * a0[2] + a0[3] * a0[3];
            const float s1 = a1[0] * a1[0] + a1[1] * a1[1] + a1[2] * a1[2] + a1[3] * a1[3];
            const float s2 = a2[0] * a2[0] + a2[1] * a2[1] + a2[2] * a2[2] + a2[3] * a2[3];
            const float s5 = a5[0] * a5[0] + a5[1] * a5[1] + a5[2] * a5[2] + a5[3] * a5[3] + a6[0] * a6[0] + a6[1] * a6[1] + a6[2] * a6[2] + a6[3] * a6[3];
            const float ssq = wave_sum(s0 + (lane < 32 ? s1 : 0.f));
            const float sskv = wave_sum((lane >= 32 ? s1 : 0.f) + (lane < 32 ? s2 : 0.f));
            const float ssv = wave_sum(s5);
            const float rq = rsqrtf(ssq * (1.f / 384.f) + EPS), rkv = rsqrtf(sskv * (1.f / 256.f) + EPS), rv = rsqrtf(ssv * (1.f / 512.f) + EPS);
            int krow, l, L; size_t kfbase; bool lat = row >= T_CTX; int b, tt;
            if (!lat) { b = row >> 8; tt = row & 255; krow = row; l = tt; L = 256; kfbase = (size_t)b * 8 * 256 * 96; }
            else { const int r2 = row - T_CTX; b = r2 >> 12; tt = r2 & 4095; krow = T_CTX + b * LLAT + 512 + tt; l = 512 + tt; L = LLAT; kfbase = KF_CTX + (size_t)b * 8 * LLAT * 96; }
            { const int c = 4 * lane; const f32x4 g = *(const f32x4*)(qag + c); u32x2 w; w.x = pk_bf16(a0[0] * rq * g[0], a0[1] * rq * g[1]); w.y = pk_bf16(a0[2] * rq * g[2], a0[3] * rq * g[3]); *(u32x2*)(QN + (size_t)row * 384 + c) = w; }
            if (lane < 32) { const int c = 256 + 4 * lane; const f32x4 g = *(const f32x4*)(qag + c); u32x2 w; w.x = pk_bf16(a1[0] * rq * g[0], a1[1] * rq * g[1]); w.y = pk_bf16(a1[2] * rq * g[2], a1[3] * rq * g[3]); *(u32x2*)(QN + (size_t)row * 384 + c) = w; }
            {
                const bool hi = lane >= 32; const int c = hi ? 4 * (lane - 32) : 128 + 4 * lane;
                const f32x4 g = *(const f32x4*)(kvg + c);
                f32x4 y;
#pragma unroll
                for (int e = 0; e < 4; ++e) y[e] = (hi ? a1[e] : a2[e]) * rkv * g[e];
                u32x2 w; w.x = pk_bf16(y[0], y[1]); w.y = pk_bf16(y[2], y[3]);
                *(u32x2*)(CKV + (size_t)krow * 256 + c) = w;
                if (!lat) *(f32x4*)(p->out + OUT_CKV + ((size_t)(b * 2 + i) * 256 + tt) * 256 + c) = y;
            }
            {
                const int j0 = ((lane - 32) & 7) * 4;
                float o[4], pr[4], op[4];
#pragma unroll
                for (int e = 0; e < 4; ++e) pr[e] = __shfl_xor(a2[e], 2);
                const int ax = j0 >> 4, pbit = (j0 >> 3) & 1, f0 = j0 & 7;
                if (lat) {
                    const float pos = (float)(ax == 0 ? (tt >> 6) : (tt & 63));
#pragma unroll
                    for (int e = 0; e < 4; ++e) { float s, cs; sincos_rr(pos * rope_inv(f0 + e), s, cs); o[e] = pbit ? (a2[e] * cs + pr[e] * s) : (a2[e] * cs - pr[e] * s); }
                } else {
#pragma unroll
                    for (int e = 0; e < 4; ++e) o[e] = a2[e];
                }
#pragma unroll
                for (int e = 0; e < 4; ++e) op[e] = __shfl_xor(o[e], 2);
                if (lane >= 32 && lane < 40) {
                    if (!lat) *(f32x4*)(p->out + OUT_KPE + ((size_t)(b * 2 + i) * 256 + tt) * 32 + j0) = (f32x4){a2[0], a2[1], a2[2], a2[3]};
                    u32x2 w;
                    if (pbit == 0) { w.x = pk_bf16(o[0], op[0]); w.y = pk_bf16(o[1], op[1]); }
                    else { w.x = pk_bf16(op[2], o[2]); w.y = pk_bf16(op[3], o[3]); }
                    *(u32x2*)(KPE + (size_t)krow * 32 + ax * 16 + 2 * (f0 + 2 * pbit)) = w;
                }
            }
            if (lane == 0) ((float*)(p->ws + WS_VN))[row] = rv;
        }
    }
    for (int it = bid_o * 8 + wid; it < 2048; it += gridDim.x * 8) {
        {
            const int r = it, b = r >> 9, pp = r & 511;
            const float* src = p->in[I_CCKV] + ((size_t)(b * 2 + i) * 512 + pp) * 256;
            const f32x4 v = *(const f32x4*)(src + 4 * lane);
            u32x2 w; w.x = pk_bf16(v[0], v[1]); w.y = pk_bf16(v[2], v[3]);
            *(u32x2*)(CKV + (size_t)(T_CTX + b * LLAT + pp) * 256 + 4 * lane) = w;
            {
                const f32x4 k = *(const f32x4*)(p->in[I_CKPE] + ((size_t)(b * 2 + i) * 512 + pp) * 32 + 4 * (lane & 7));
                const int j0 = 4 * (lane & 7), ax = j0 >> 4, pbit = (j0 >> 3) & 1, f0 = j0 & 7;
                float op[4];
#pragma unroll
                for (int e = 0; e < 4; ++e) op[e] = __shfl_xor(k[e], 2);
                if (lane < 8) {
                    u32x2 w;
                    if (pbit == 0) { w.x = pk_bf16(k[0], op[0]); w.y = pk_bf16(k[1], op[1]); }
                    else { w.x = pk_bf16(op[2], k[2]); w.y = pk_bf16(op[3], k[3]); }
                    *(u32x2*)(KPE + (size_t)(T_CTX + b * LLAT + pp) * 32 + ax * 16 + 2 * (f0 + 2 * pbit)) = w;
                }
            }
        }
    }
}

constexpr int AK_ROW = 208, AV_ROW = 136, AK_BUF = 64 * AK_ROW, AV_BUF = 64 * AV_ROW, AV_OFF = 2 * AK_BUF;
#define MFMA32(a, b, c) __builtin_amdgcn_mfma_f32_32x32x16_bf16((a), (b), (c), 0, 0, 0)
DI void attn_unit(int tid_o, LAS unsigned char* lds, const bf16_t* Qb, const bf16_t* Kb, const bf16_t* Vb, int L, bf16_t* Ob) {
    const int tid = tid_o, wid = tid >> 6, lane = tid & 63, r32 = lane & 31, hh = lane >> 5;
    bf16x8 qf[6];
    { const bf16_t* qp = Qb + (size_t)(wid * 32 + r32) * 768 + hh * 8;
#pragma unroll
        for (int s = 0; s < 6; ++s) qf[s] = *(const bf16x8*)(qp + s * 16); }
    const bool lo256 = tid < 256;
    const int c1 = tid + 512;
    const bf16_t* g0 = Kb; const unsigned go0 = (tid / 12) * 96 + (tid % 12) * 8;
    const unsigned l0 = (tid / 12) * AK_ROW + (tid % 12) * 16;
    const bf16_t* g1 = lo256 ? Kb : Vb; const unsigned go1 = lo256 ? (c1 / 12) * 96 + (c1 % 12) * 8 : (unsigned)((tid - 256) >> 3) * L + ((tid - 256) & 7) * 8;
    const unsigned l1 = lo256 ? (c1 / 12) * AK_ROW + (c1 % 12) * 16 : AV_OFF + ((tid - 256) >> 3) * AV_ROW + ((tid - 256) & 7) * 16;
    const bf16_t* g2 = Vb; const unsigned go2 = (unsigned)((tid + 256) >> 3) * L + ((tid + 256) & 7) * 8;
    const unsigned l2 = AV_OFF + ((tid + 256) >> 3) * AV_ROW + ((tid + 256) & 7) * 16;
    const int st1 = lo256 ? 64 * 96 : 64;
    const int nt = L / 64;
    u32x4 s0r, s1r, s2r;
    s0r = *(const u32x4*)(g0 + go0); s1r = *(const u32x4*)(g1 + go1); if (lo256) s2r = *(const u32x4*)(g2 + go2);
    {
        *(LAS u32x4*)(lds + l0) = s0r;
        if (lo256) { *(LAS u32x4*)(lds + l1) = s1r; *(LAS u32x2*)(lds + l2) = (u32x2){s2r.x, s2r.y}; *(LAS u32x2*)(lds + l2 + 8) = (u32x2){s2r.z, s2r.w}; }
        else { *(LAS u32x2*)(lds + l1) = (u32x2){s1r.x, s1r.y}; *(LAS u32x2*)(lds + l1 + 8) = (u32x2){s1r.z, s1r.w}; }
    }
    __syncthreads();
    f32x16 o0, o1;
#pragma unroll
    for (int e = 0; e < 16; ++e) { o0[e] = 0.f; o1[e] = 0.f; }
    float mrun = -INFINITY, lsum = 0.f;
    for (int kt = 0; kt < nt; ++kt) {
        const int buf = kt & 1;
        const bool pre = kt + 1 < nt;
        if (pre) {
            s0r = *(const u32x4*)(g0 + (go0 + (unsigned)(kt + 1) * 64 * 96)); s1r = *(const u32x4*)(g1 + (go1 + (unsigned)(kt + 1) * st1)); if (lo256) s2r = *(const u32x4*)(g2 + (go2 + (unsigned)(kt + 1) * 64));
        }
        f32x16 sa, sb;
#pragma unroll
        for (int e = 0; e < 16; ++e) { sa[e] = 0.f; sb[e] = 0.f; }
        const LAS unsigned char* kb = lds + buf * AK_BUF + r32 * AK_ROW + hh * 16;
        __builtin_amdgcn_s_setprio(1);
#pragma unroll
        for (int s = 0; s < 6; ++s) {
            const bf16x8 a0 = *(const LAS bf16x8*)(kb + s * 32), a1 = *(const LAS bf16x8*)(kb + 32 * AK_ROW + s * 32);
            sa = MFMA32(a0, qf[s], sa); sb = MFMA32(a1, qf[s], sb);
        }
        __builtin_amdgcn_s_setprio(0);
        __builtin_amdgcn_sched_barrier(0);
        float mx = sa[0];
#pragma unroll
        for (int e = 1; e < 16; ++e) mx = fmaxf(mx, sa[e]);
#pragma unroll
        for (int e = 0; e < 16; ++e) mx = fmaxf(mx, sb[e]);
        mx = fmaxf(mx, __shfl_xor(mx, 32));
        const float mn = fmaxf(mrun, mx);
        const float alpha = __builtin_amdgcn_exp2f(mrun - mn);
        mrun = mn;
        float ps = 0.f;
#pragma unroll
        for (int e = 0; e < 16; ++e) { sa[e] = __builtin_amdgcn_exp2f(sa[e] - mn); ps += sa[e]; }
#pragma unroll
        for (int e = 0; e < 16; ++e) { sb[e] = __builtin_amdgcn_exp2f(sb[e] - mn); ps += sb[e]; }
        lsum = lsum * alpha + ps;
        o0 = o0 * alpha; o1 = o1 * alpha;
        __builtin_amdgcn_sched_barrier(0);
        const LAS unsigned char* vb = lds + AV_OFF + buf * AV_BUF + r32 * AV_ROW + hh * 8;
#pragma unroll
        for (int kb2 = 0; kb2 < 2; ++kb2)
#pragma unroll
            for (int s = 0; s < 2; ++s) {
                u32x4 pw;
                if (kb2 == 0) { pw.x = pk_bf16(sa[8 * s + 0], sa[8 * s + 1]); pw.y = pk_bf16(sa[8 * s + 2], sa[8 * s + 3]); pw.z = pk_bf16(sa[8 * s + 4], sa[8 * s + 5]); pw.w = pk_bf16(sa[8 * s + 6], sa[8 * s + 7]); }
                else { pw.x = pk_bf16(sb[8 * s + 0], sb[8 * s + 1]); pw.y = pk_bf16(sb[8 * s + 2], sb[8 * s + 3]); pw.z = pk_bf16(sb[8 * s + 4], sb[8 * s + 5]); pw.w = pk_bf16(sb[8 * s + 6], sb[8 * s + 7]); }
                const bf16x8 pb = __builtin_bit_cast(bf16x8, pw);
                const int ko = (kb2 * 32 + 16 * s) * 2;
                const u32x2 v0l = *(const LAS u32x2*)(vb + ko), v0h = *(const LAS u32x2*)(vb + ko + 16);
                const u32x2 v1l = *(const LAS u32x2*)(vb + 32 * AV_ROW + ko), v1h = *(const LAS u32x2*)(vb + 32 * AV_ROW + ko + 16);
                const bf16x8 va0 = __builtin_bit_cast(bf16x8, (u32x4){v0l.x, v0l.y, v0h.x, v0h.y});
                const bf16x8 va1 = __builtin_bit_cast(bf16x8, (u32x4){v1l.x, v1l.y, v1h.x, v1h.y});
                o0 = MFMA32(va0, pb, o0); o1 = MFMA32(va1, pb, o1);
            }
        if (pre) {
            const unsigned bo = (buf ^ 1) * AK_BUF, vo = (buf ^ 1) * AV_BUF;
            *(LAS u32x4*)(lds + bo + l0) = s0r;
            if (lo256) { *(LAS u32x4*)(lds + bo + l1) = s1r; *(LAS u32x2*)(lds + vo + l2) = (u32x2){s2r.x, s2r.y}; *(LAS u32x2*)(lds + vo + l2 + 8) = (u32x2){s2r.z, s2r.w}; }
            else { *(LAS u32x2*)(lds + vo + l1) = (u32x2){s1r.x, s1r.y}; *(LAS u32x2*)(lds + vo + l1 + 8) = (u32x2){s1r.z, s1r.w}; }
        }
        __syncthreads();
    }
    const float lt = lsum + __shfl_xor(lsum, 32);
    const float inv = 1.f / lt;
    bf16_t* op = Ob + (size_t)(wid * 32 + r32) * D + 4 * hh;
#pragma unroll
    for (int g = 0; g < 4; ++g) {
        u32x2 w0; w0.x = pk_bf16(o0[4 * g] * inv, o0[4 * g + 1] * inv); w0.y = pk_bf16(o0[4 * g + 2] * inv, o0[4 * g + 3] * inv);
        u32x2 w1; w1.x = pk_bf16(o1[4 * g] * inv, o1[4 * g + 1] * inv); w1.y = pk_bf16(o1[4 * g + 2] * inv, o1[4 * g + 3] * inv);
        *(u32x2*)(op + 8 * g) = w0; *(u32x2*)(op + 32 + 8 * g) = w1;
    }
}
DI void attn_phase(int tid_o, int bid_o, KP p, LAS unsigned char* lds) {
    const bf16_t* Q = (const bf16_t*)(p->ws + WS_Q); const bf16_t* KF = (const bf16_t*)(p->ws + WS_KF); const bf16_t* VT = (const bf16_t*)(p->ws + WS_VT);
    bf16_t* MIX = (bf16_t*)((unsigned char*)p->out);
    for (int u = bid_o; u < 768; u += gridDim.x) {
        if (u < 512) {
            const int x = u & 7, r = u >> 3, bh = x * 4 + (r >> 4), qb = r & 15, b = bh >> 3, h = bh & 7;
            const int tok0 = T_CTX + b * 4096 + qb * 256;
            attn_unit(tid_o, lds, Q + (size_t)tok0 * 768 + h * 96, KF + KF_CTX + (size_t)(b * 8 + h) * LLAT * 96, VT + VT_CTX + (size_t)(b * 8 + h) * 64 * LLAT, LLAT, MIX + (size_t)tok0 * D + h * 64);
        } else {
            const int bh = u - 512, b = bh >> 3, h = bh & 7;
            const int tok0 = b * 256;
            attn_unit(tid_o, lds, Q + (size_t)tok0 * 768 + h * 96, KF + (size_t)(b * 8 + h) * 256 * 96, VT + (size_t)(b * 8 + h) * 64 * 256, 256, MIX + (size_t)tok0 * D + h * 64);
        }
    }
}

DI void spatial_phase(int tid_o, int bid_o, KP p, LAS unsigned char* lds, int i) {
    const int tid = tid_o, wid = tid >> 6, lane = tid & 63, fr = lane & 15, fq = lane >> 4;
    const float* RSV = (const float*)(p->ws + WS_VN); const bf16_t* Z = (const bf16_t*)(p->ws + WS_Z); const float* VG = p->in[I_VG] + i * 512; const bf16_t* WSP = (const bf16_t*)(p->ws + WS_WSP) + (size_t)i * 8 * 128 * 128;
    bf16_t* MIX = (bf16_t*)((unsigned char*)p->out);
    const float* bs = p->in[I_BSP] + i * 8 * 128;
    const int NU = (T / 128) * 8;
    u32x4 vv[2]; float vr[2];
    if (bid_o < NU) {
        const int chunk = bid_o >> 3, g = bid_o & 7, tok0 = chunk * 128;
#pragma unroll
        for (int k = 0; k < 2; ++k) { const int id = tid + 512 * k, q = id >> 3, c0 = (id & 7) * 8; vv[k] = *(const u32x4*)(Z + (size_t)(tok0 + q) * NZ + 1280 + g * 64 + c0); vr[k] = RSV[tok0 + q]; }
    }
    const bool ginv = (gridDim.x & 7) == 0;
    bf16x8 wa[4]; float bias = 0.f;
    if (ginv && bid_o < NU) {
        const int g = bid_o & 7;
#pragma unroll
        for (int k = 0; k < 4; ++k) wa[k] = *(const bf16x8*)(WSP + ((size_t)g * 128 + 16 * wid + fr) * 128 + 32 * k + fq * 8);
        bias = bs[g * 128 + 16 * wid + fr];
    }
    for (int u = bid_o; u < NU; u += gridDim.x) {
        const int chunk = u >> 3, g = u & 7, tok0 = chunk * 128;
        const int prow = 16 * wid + fr, tok = tok0 + prow;
        u32x2 uu[4];
#pragma unroll
        for (int n = 0; n < 4; ++n) uu[n] = *(const u32x2*)(Z + (size_t)tok * NZ + 768 + g * 64 + 16 * n + 4 * fq);
#pragma unroll
        for (int k = 0; k < 2; ++k) {
            const int id = tid + 512 * k, q = id >> 3, c0 = (id & 7) * 8;
            const u32x4 v = vv[k]; const float r = vr[k];
            const f32x4 ga = *(const f32x4*)(VG + g * 64 + c0), gb = *(const f32x4*)(VG + g * 64 + c0 + 4);
            LAS bf16_t* dst = (LAS bf16_t*)(lds + c0 * 272 + q * 2);
            dst[0 * 136] = f2bf(bf_lo(v.x) * r * ga[0]); dst[1 * 136] = f2bf(bf_hi(v.x) * r * ga[1]); dst[2 * 136] = f2bf(bf_lo(v.y) * r * ga[2]); dst[3 * 136] = f2bf(bf_hi(v.y) * r * ga[3]);
            dst[4 * 136] = f2bf(bf_lo(v.z) * r * gb[0]); dst[5 * 136] = f2bf(bf_hi(v.z) * r * gb[1]); dst[6 * 136] = f2bf(bf_lo(v.w) * r * gb[2]); dst[7 * 136] = f2bf(bf_hi(v.w) * r * gb[3]);
        }
        __syncthreads();
        { const int un = u + gridDim.x;
          if (un < NU) { const int chn = un >> 3, gn = un & 7, tk0 = chn * 128;
#pragma unroll
            for (int k = 0; k < 2; ++k) { const int id = tid + 512 * k, q = id >> 3, c0 = (id & 7) * 8; vv[k] = *(const u32x4*)(Z + (size_t)(tk0 + q) * NZ + 1280 + gn * 64 + c0); vr[k] = RSV[tk0 + q]; } } }
        if (!ginv) {
#pragma unroll
            for (int k = 0; k < 4; ++k) wa[k] = *(const bf16x8*)(WSP + ((size_t)g * 128 + 16 * wid + fr) * 128 + 32 * k + fq * 8);
            bias = bs[g * 128 + prow];
        }
        f32x4 acc[4];
#pragma unroll
        for (int n = 0; n < 4; ++n) acc[n] = (f32x4){0.f, 0.f, 0.f, 0.f};
#pragma unroll
        for (int k = 0; k < 4; ++k) {
#pragma unroll
            for (int n = 0; n < 4; ++n) {
                const bf16x8 b = *(const LAS bf16x8*)(lds + (16 * n + fr) * 272 + (32 * k + fq * 8) * 2);
                acc[n] = __builtin_amdgcn_mfma_f32_16x16x32_bf16(b, wa[k], acc[n], 0, 0, 0);
            }
        }
#pragma unroll
        for (int n = 0; n < 4; ++n) {
            const int ch = g * 64 + 16 * n + 4 * fq;
            u32x2 w; w.x = pk_bf16(bf_lo(uu[n].x) * (acc[n][0] + bias), bf_hi(uu[n].x) * (acc[n][1] + bias)); w.y = pk_bf16(bf_lo(uu[n].y) * (acc[n][2] + bias), bf_hi(uu[n].y) * (acc[n][3] + bias));
            *(u32x2*)(MIX + (size_t)tok * D + 512 + ch) = w;
        }
        __syncthreads();
    }
}

template <int HW>
DI void pd_item(const bf16_t* hb, bf16_t* pb, int tt0, int len) {
    constexpr int NRW = 8 + 2 * HW;
    u32x4 rw[NRW];
#pragma unroll
    for (int k = 0; k < NRW; ++k) {
        const int t2 = tt0 - HW + k;
        rw[k] = (t2 >= 0 && t2 < len) ? *(const u32x4*)(hb + (size_t)t2 * D) : (u32x4){0u, 0u, 0u, 0u};
    }
    float sum[8];
#pragma unroll
    for (int e = 0; e < 8; ++e) sum[e] = 0.f;
#pragma unroll
    for (int k = 0; k < 2 * HW; ++k) {
        sum[0] += bf_lo(rw[k].x); sum[1] += bf_hi(rw[k].x); sum[2] += bf_lo(rw[k].y); sum[3] += bf_hi(rw[k].y); sum[4] += bf_lo(rw[k].z); sum[5] += bf_hi(rw[k].z); sum[6] += bf_lo(rw[k].w); sum[7] += bf_hi(rw[k].w);
    }
#pragma unroll
    for (int j = 0; j < 8; ++j) {
        const int tt = tt0 + j, lo = max(tt - HW, 0), hi = min(tt + HW, len);
        const float ic = 1.f / (float)(hi - lo);
        const u32x4 v = rw[j + HW];
        u32x4 w;
        w.x = pk_bf16(sum[0] * ic - bf_lo(v.x), sum[1] * ic - bf_hi(v.x)); w.y = pk_bf16(sum[2] * ic - bf_lo(v.y), sum[3] * ic - bf_hi(v.y));
        w.z = pk_bf16(sum[4] * ic - bf_lo(v.z), sum[5] * ic - bf_hi(v.z)); w.w = pk_bf16(sum[6] * ic - bf_lo(v.w), sum[7] * ic - bf_hi(v.w));
        *(u32x4*)(pb + (size_t)tt * D) = w;
        if (j < 7) {
            const u32x4 a = rw[j + 2 * HW], s2 = rw[j];
            sum[0] += bf_lo(a.x) - bf_lo(s2.x); sum[1] += bf_hi(a.x) - bf_hi(s2.x); sum[2] += bf_lo(a.y) - bf_lo(s2.y); sum[3] += bf_hi(a.y) - bf_hi(s2.y);
            sum[4] += bf_lo(a.z) - bf_lo(s2.z); sum[5] += bf_hi(a.z) - bf_hi(s2.z); sum[6] += bf_lo(a.w) - bf_lo(s2.w); sum[7] += bf_hi(a.w) - bf_hi(s2.w);
        }
    }
}
DI void pooldiff_phase(int tid_o, int bid_o, KP p) {
    const bf16_t* H = (const bf16_t*)(p->ws + WS_DELTA); bf16_t* PD = (bf16_t*)(p->ws + WS_PD);
    const int wid = tid_o >> 6, lane = tid_o & 63;
    for (int wi = bid_o * 8 + wid; wi < (T / 16) * 4; wi += gridDim.x * 8) {
        const int gi = wi & 3, tb = (wi >> 2) * 2 + (lane >> 5), c0 = gi * 256 + (lane & 31) * 8;
        const int tok0 = tb * 8;
        int s0, len;
        if (tok0 < T_CTX) { s0 = tok0 & ~255; len = 256; } else { s0 = T_CTX + ((tok0 - T_CTX) & ~4095); len = 4096; }
        const int tt0 = tok0 - s0;
        const bf16_t* hb = H + (size_t)s0 * D + c0; bf16_t* pb = PD + (size_t)s0 * D + c0;
        if (gi == 0) pd_item<1>(hb, pb, tt0, len);
        else if (gi == 1) pd_item<2>(hb, pb, tt0, len);
        else if (gi == 2) pd_item<4>(hb, pb, tt0, len);
        else pd_item<8>(hb, pb, tt0, len);
    }
}

DI void run_phase(int tid_o, int bid_o, KP p, LAS unsigned char* lds, int ph) {
    const float* MOD = (const float*)(p->ws + WS_MOD);

#ifndef DIS_PRO
    if (ph == 0) { prologue_phase(tid_o, bid_o, p, lds); return; }
#endif


#ifndef DIS_NORMF
    if (ph == 31) { norm_phase(tid_o, bid_o, p, 0, 0, false, true); return; }
#endif

    const int q = ph - 1, pair = q / 15, r = q % 15;
    const bool ab = r < 9;
    const int layer = pair * 2 + (ab ? 0 : 1), s = ab ? r : r - 9, i = pair;
    const int slot_n2 = ab ? 6 : 3;

#ifndef DIS_NORM
    if (s == 0) { norm_phase(tid_o, bid_o, p, layer, 0, layer == 0, false); return; }
    if (s == slot_n2) { norm_phase(tid_o, bid_o, p, layer, 1, false, false); return; }
#endif

    if (s == slot_n2 + 1) {
        pg8::Gemm g{(const bf16_t*)(p->ws + WS_DELTA), (const bf16_t*)(p->ws + WS_WFF1) + (size_t)layer * FF * 1024, 1024, 1024, 1024, 0, T / 256, FF / 256, 0, nullptr, nullptr, 0, 0, 0};
        Epi<EM_FF1> E{(bf16_t*)(p->ws + WS_FFH), nullptr, nullptr, nullptr, nullptr, nullptr, nullptr};

#ifndef DIS_FF1
        pg8::gemm_phase(tid_o, bid_o, lds, g, E);
#endif
        return;
    }
    if (s == slot_n2 + 2) {

        pg8::Gemm g{(const bf16_t*)(p->ws + WS_FFH), (const bf16_t*)(p->ws + WS_WFF2) + (size_t)layer * 1024 * FF, FF, FF, FF, 0, T / 256, 4, 0, nullptr, nullptr, 1, 1, 1};
        Epi<EM_RES> E{(bf16_t*)(p->ws + WS_H), nullptr, nullptr, nullptr, MOD + (size_t)layer * 5 * MODW + 5 * D, nullptr, nullptr};
#ifndef DIS_FF2
        pg8::gemm_phase(tid_o, bid_o, lds, g, E); return;
#else
        return;
#endif
    }
    if (ab) {
        if (s == 1) {
            pg8::Gemm g{(const bf16_t*)(p->ws + WS_DELTA), (const bf16_t*)(p->ws + WS_WIN) + (size_t)i * NZ * 1024, 1024, 1024, 1024, 0, T / 256, NZ / 256, 0, nullptr, nullptr, 0, 0, 0};
            Epi<EM_Z> E{(bf16_t*)(p->ws + WS_Z), nullptr, nullptr, nullptr, nullptr, nullptr, nullptr};
#ifndef DIS_ZIN
            pg8::gemm_phase(tid_o, bid_o, lds, g, E); return;
#else
            return;
#endif
        }
#ifndef DIS_ROWOP
        if (s == 2) { rowop_phase(tid_o, bid_o, p, i); return; }
#else
        if (s == 2) return;
#endif
        if (s == 3) {
            { pg8::Gemm g{(const bf16_t*)(p->ws + WS_QN), (const bf16_t*)(p->ws + WS_WQB) + (size_t)i * 768 * 384, 384, 384, 384, 0, T / 256, 3, 0, nullptr, nullptr, 0, 0, 0};
              Epi<EM_Q> E{(bf16_t*)(p->ws + WS_Q), nullptr, nullptr, nullptr, nullptr, nullptr, nullptr};
#ifndef DIS_Q
              pg8::gemm_phase(tid_o, bid_o, lds, g, E); }
#else
              }
#endif
            { pg8::Gemm g{(const bf16_t*)(p->ws + WS_CKV), (const bf16_t*)(p->ws + WS_WK) + (size_t)i * 512 * 256, 256, 256, 256, 0, KR / 256, 2, 224, nullptr, nullptr, 0, 0, 0};
              Epi<EM_K> E{(bf16_t*)(p->ws + WS_KF), nullptr, nullptr, nullptr, nullptr, nullptr, (const bf16_t*)(p->ws + WS_KPE)};
#ifndef DIS_K
              pg8::gemm_phase(tid_o, bid_o, lds, g, E); }
#else
              }
#endif
            { pg8::Gemm g{(const bf16_t*)(p->ws + WS_WV) + (size_t)i * 512 * 256, (const bf16_t*)(p->ws + WS_CKV), 256, 256, 256, 0, 2, KR / 256, 208, nullptr, nullptr, 0, 0, 0};
              Epi<EM_VT> E{(bf16_t*)(p->ws + WS_VT), nullptr, nullptr, nullptr, nullptr, nullptr, nullptr};
#ifndef DIS_V
              pg8::gemm_phase(tid_o, bid_o, lds, g, E); }
#else
              }
#endif
#ifndef DIS_SPAT
            spatial_phase(tid_o, bid_o, p, lds, i);
#else

#endif
            return;
        }
#ifndef DIS_ATTN
        if (s == 4) { attn_phase(tid_o, bid_o, p, lds); return; }
#else
        if (s == 4) return;
#endif
        if (s == 5) {
            pg8::Gemm g{(const bf16_t*)((unsigned char*)p->out), (const bf16_t*)(p->ws + WS_WOUT) + (size_t)i * 1024 * 1024, 1024, 1024, 1024, 0, T / 256, 4, 0, nullptr, nullptr, 0, 0, 1};
            Epi<EM_RES> E{(bf16_t*)(p->ws + WS_H), nullptr, nullptr, nullptr, MOD + (size_t)layer * 5 * MODW + 2 * D, nullptr, nullptr};
#ifndef DIS_OUT
            pg8::gemm_phase(tid_o, bid_o, lds, g, E); return;
#else
            return;
#endif
        }
    } else {
#ifndef DIS_PD
        if (s == 1) { pooldiff_phase(tid_o, bid_o, p); return; }
#else
        if (s == 1) return;
#endif
        if (s == 2) {
            pg8::Gemm g{(const bf16_t*)(p->ws + WS_PD), (const bf16_t*)(p->ws + WS_WPOOL) + (size_t)i * 1024 * 256, 1024, 256, 256, 256, T / 256, 4, 0, nullptr, nullptr, 0, 0, 1};
            Epi<EM_RES> E{(bf16_t*)(p->ws + WS_H), nullptr, nullptr, nullptr, MOD + (size_t)layer * 5 * MODW + 2 * D, p->in[I_PSCALE] + i * D, nullptr};
#ifndef DIS_POOL
            pg8::gemm_phase(tid_o, bid_o, lds, g, E); return;
#else
            return;
#endif
        }
    }
}


#define XB_TMO      128
#define XB_XCNT(j)  (256  + 64 * (j))
#define XB_XSUB(j)  (1280 + 64 * (j))
#define XB_XGEN(j)  (2304 + 64 * (j))
#define XB_TOP      3328
#define XB_TOPGEN   3392
#define XCD_BAR_WORDS 3456
#define XB_SPIN_CAP (1u << 22)
DI unsigned xb_ld(unsigned* p)              { return __hip_atomic_load(p, __ATOMIC_RELAXED, __HIP_MEMORY_SCOPE_AGENT); }
DI unsigned xb_add(unsigned* p, unsigned v) { return __hip_atomic_fetch_add(p, v, __ATOMIC_RELAXED, __HIP_MEMORY_SCOPE_AGENT); }
DI unsigned xb_xcc_id() { return (unsigned)__builtin_amdgcn_s_getreg((3 << 11) | 20) & 0xFu; }
#define XB_SPIN(cond, bar) do { unsigned _sp = 0; while (cond) { __builtin_amdgcn_s_sleep(1); \
    if ((++_sp & 255u) == 0u) { if (xb_ld(&(bar)[XB_TMO])) break; if (_sp > XB_SPIN_CAP) { atomicAdd(&(bar)[XB_TMO], 1u); break; } } } } while (0)
DI void xcd_barrier_complete(unsigned* bar, unsigned x, unsigned& nloc, unsigned& nx) {
    const unsigned G = gridDim.x;
    unsigned sum, cnt, mine, sp = 0u;
    for (;;) {
        sum = 0u; cnt = 0u; mine = 0u;
#pragma unroll
        for (unsigned j = 0; j < 16; ++j) { const unsigned c = xb_ld(&bar[XB_XCNT(j)]); sum += c; cnt += (c > 0u) ? 1u : 0u; mine = (j == x) ? c : mine; }
        if (sum == G) break;
        __builtin_amdgcn_s_sleep(1);
        if ((++sp & 255u) == 0u) { if (xb_ld(&bar[XB_TMO])) break; if (sp > XB_SPIN_CAP) { atomicAdd(&bar[XB_TMO], 1u); break; } }
    }
    nloc = mine > 0u ? mine : 1u; nx = cnt > 0u ? cnt : 1u;
}
DI void xcd_barrier(unsigned* bar, unsigned x, volatile LAS unsigned* st, int tid) {
    asm volatile("s_waitcnt vmcnt(0)" ::: "memory");
    __syncthreads();
    if (tid == 0) {
        __builtin_amdgcn_s_waitcnt(0);
        unsigned nloc = st[0], nx = st[1];
        if (nloc == 0u) { xcd_barrier_complete(bar, x, nloc, nx); st[0] = nloc; st[1] = nx; }
        const unsigned old = xb_add(&bar[XB_XSUB(x)], 1u);
        const unsigned gen = old / nloc;
        if (old + 1u == (gen + 1u) * nloc) {
            __builtin_amdgcn_fence(__ATOMIC_RELEASE, "agent");
            asm volatile("s_waitcnt vmcnt(0)" ::: "memory");
            const unsigned og = xb_add(&bar[XB_TOP], 1u);
            const unsigned tg = og / nx;
            if (og + 1u == (tg + 1u) * nx) xb_add(&bar[XB_TOPGEN], 1u);
            else XB_SPIN(xb_ld(&bar[XB_TOPGEN]) == tg, bar);
            __builtin_amdgcn_fence(__ATOMIC_ACQUIRE, "agent");
            xb_add(&bar[XB_XGEN(x)], 1u);
            asm volatile("s_waitcnt vmcnt(0)" ::: "memory");
        } else {
            XB_SPIN(xb_ld(&bar[XB_XGEN(x)]) == gen, bar);
            __builtin_amdgcn_fence(__ATOMIC_ACQUIRE, "agent");
            asm volatile("s_waitcnt vmcnt(0)" ::: "memory");
        }
    }
    __syncthreads();
}

#ifndef REPMASK
#define REPMASK 0
#endif
DI int phase_class(int ph) {
    if (ph == 0) return 0;
    if (ph == 31) return 15;
    const int q = ph - 1, r = q % 15; const bool ab = r < 9; const int s = ab ? r : r - 9, n2 = ab ? 6 : 3;
    if (s == 0 || s == n2) return 1;
    if (s == n2 + 1) return 7;
    if (s == n2 + 2) return 15;
    if (ab) { if (s == 1) return 2; if (s == 2) return 3; if (s == 3) return 4; if (s == 4) return 5; if (s == 5) return ph == 6 ? 6 : 15; }
    else { if (s == 1) return 8; }
    return 15;
}
__global__ void __launch_bounds__(512, 2) fwd_megakernel(Params p) {
    extern __shared__ __attribute__((aligned(16))) unsigned char smem[];
    LAS unsigned char* lds = (LAS unsigned char*)smem;
    volatile LAS unsigned* xst = (volatile LAS unsigned*)(lds + XST_OFF);
    unsigned* bar = (unsigned*)(p.ws + WS_CTL);
    const unsigned xcc = xb_xcc_id();
    if (p.coop) {
        if (threadIdx.x == 0) { xst[0] = 0u; xst[1] = 0u; (void)xb_add(&bar[XB_XCNT(xcc)], 1u); }
        __syncthreads();
    }
    if (p.ph_lo < 0) cg::this_grid().sync();
    for (int ph = p.ph_lo; ph < p.ph_hi; ++ph) {
#if REPMASK
        const int reps = 1 + ((REPMASK >> phase_class(ph)) & 1);
#else
        const int reps = 1;
#endif
#pragma nounroll
        for (int rep = 0; rep < reps; ++rep) {
            int tid_o = (int)__builtin_amdgcn_workitem_id_x(), bid_o = (int)__builtin_amdgcn_workgroup_id_x();
            asm volatile("" : "+v"(tid_o)); asm volatile("" : "+s"(bid_o));
            KP kp = (KP)__builtin_amdgcn_kernarg_segment_ptr(); asm volatile("" : "+s"(kp));
            run_phase(tid_o, bid_o, kp, lds, ph);
            if (rep + 1 < reps || ph + 1 < p.ph_hi) xcd_barrier(bar, xcc, xst, tid_o);
        }
    }
}

extern "C" void kernel_launch(void* const* d_in, const int* in_sizes, int n_in, void* d_out, int out_size, void* d_ws, size_t ws_size, hipStream_t stream) {
    static int grid = 0;
    if (grid == 0) {
        if (n_in != 24 || ws_size < WS_TOTAL) { fprintf(stderr, "kernel_launch: unexpected n_in %d / ws_size %zu (need %zu)\n", n_in, ws_size, (size_t)WS_NEED); grid = -1; return; }
        int dev = 0, cus = 0, per_cu = 0;
        hipGetDevice(&dev);
        hipDeviceGetAttribute(&cus, hipDeviceAttributeMultiprocessorCount, dev);
        if (hipFuncSetAttribute((const void*)fwd_megakernel, hipFuncAttributeMaxDynamicSharedMemorySize, LDS_BYTES) != hipSuccess) { fprintf(stderr, "kernel_launch: hipFuncSetAttribute failed\n"); grid = -1; return; }
        if (hipOccupancyMaxActiveBlocksPerMultiprocessor(&per_cu, (const void*)fwd_megakernel, 512, LDS_BYTES) != hipSuccess || per_cu < 1) { fprintf(stderr, "kernel_launch: occupancy query gave %d\n", per_cu); per_cu = 1; (void)hipGetLastError(); }
        grid = cus * 1;
        if (grid <= 0) grid = 256;
    }
    if (grid < 0) return;
    Params p{};
    for (int i = 0; i < 24; ++i) p.in[i] = (const float*)d_in[i];
    p.out = (float*)d_out; p.ws = (unsigned char*)d_ws;
#if MK_COOP
    p.ph_lo = 0; p.ph_hi = NPHASE; p.coop = 1;
    (void)hipMemsetAsync((char*)d_ws + WS_CTL, 0, CTL_BYTES, stream);
    void* args[] = {&p};
    hipError_t e = hipLaunchCooperativeKernel((const void*)fwd_megakernel, dim3(grid), dim3(512), args, LDS_BYTES, stream);
    if (e != hipSuccess) fprintf(stderr, "cooperative launch failed: %s (grid %d)\n", hipGetErrorString(e), grid);
#else
    for (int ph = 0; ph < NPHASE; ++ph) {
        p.ph_lo = ph; p.ph_hi = ph + 1;
        hipLaunchKernelGGL(fwd_megakernel, dim3(grid), dim3(512), LDS_BYTES, stream, p);
    }
#endif
}
```
